# Optimizing an MI355X kernel written in HIP

```python
import math
import jax, jax.numpy as jnp
from jax import lax
import numpy as np

D_MODEL = 1024
BATCH = 8
SEQ = 2048
DEPTH = 1

CHUNK = 64
A_HEADS = 8
A_HEAD_DIM = 64
A_LEFT_CHUNKS = 8
A_MAX_REL = 128
A_WIDTH = A_HEADS * A_HEAD_DIM
B_HEADS = 8
B_NOPE_DIM = 64
B_ROPE_DIM = 32
B_V_DIM = 64
B_Q_LORA = 384
B_KV_LORA = 256
B_QK_DIM = B_NOPE_DIM + B_ROPE_DIM
B_WIDTH = B_HEADS * B_V_DIM
ROPE_THETA = 10000.0
Q_BLOCK = 128
IN_SIZES = (A_WIDTH, A_WIDTH, A_WIDTH, B_Q_LORA, B_KV_LORA, B_ROPE_DIM, D_MODEL, D_MODEL)
IN_SPLITS = tuple(int(v) for v in np.cumsum(IN_SIZES)[:-1])
N_IN = int(sum(IN_SIZES))
N_EXPERTS = 32
TOP_K = 4
D_EXPERT = D_MODEL
SWIGLU_LIMIT = 7.0
SWIGLU_ALPHA = 1.702
EXPERT_BLOCK = 256
DEEPNORM_ALPHA = (2.0 * DEPTH) ** 0.25
DEEPNORM_BETA = (8.0 * DEPTH) ** -0.25
LN_EPS = 1e-5
RMS_EPS = 1e-6
NEG_INF = -1e30

kernel_name = "hybrid_chunked_mla_moe_deepnorm_adaln"


def layer_norm(x, g, b):
    xf = x.astype(jnp.float32)
    mu = jnp.mean(xf, axis=-1, keepdims=True)
    var = jnp.mean(jnp.square(xf - mu), axis=-1, keepdims=True)
    return ((xf - mu) * lax.rsqrt(var + LN_EPS) * g.astype(jnp.float32) + b.astype(jnp.float32)).astype(x.dtype)


def rms_norm(x, g):
    xf = x.astype(jnp.float32)
    ms = jnp.mean(jnp.square(xf), axis=-1, keepdims=True)
    return (xf * lax.rsqrt(ms + RMS_EPS) * g.astype(jnp.float32)).astype(x.dtype)


def rope(x, positions):
    half = x.shape[-1] // 2
    freqs = ROPE_THETA ** (-jnp.arange(half, dtype=jnp.float32) / half)
    ang = positions.astype(jnp.float32)[:, :, None, None] * freqs
    cos, sin = jnp.cos(ang), jnp.sin(ang)
    xf = x.astype(jnp.float32)
    x1, x2 = xf[..., :half], xf[..., half:]
    return jnp.concatenate([x1 * cos - x2 * sin, x2 * cos + x1 * sin], axis=-1).astype(x.dtype)


def chunked_relpos_attention(q, k, v, rel_bias):
    bsz, seq = q.shape[0], q.shape[1]
    n_chunks = seq // CHUNK
    left = A_LEFT_CHUNKS * CHUNK
    band = left + CHUNK
    qc = q.reshape(bsz, n_chunks, CHUNK, A_HEADS, A_HEAD_DIM)
    pad = ((0, 0), (left, 0), (0, 0), (0, 0))
    band_idx = (jnp.arange(n_chunks) * CHUNK)[:, None] + jnp.arange(band)[None, :]
    kb = jnp.pad(k, pad)[:, band_idx]
    vb = jnp.pad(v, pad)[:, band_idx]
    valid = band_idx >= left
    dist = jnp.arange(CHUNK)[:, None] - jnp.arange(band)[None, :] + left
    bias = rel_bias[:, jnp.clip(dist, -A_MAX_REL, A_MAX_REL) + A_MAX_REL].astype(jnp.float32)
    s = jnp.einsum('bcqhd,bckhd->bhcqk', qc, kb, preferred_element_type=jnp.float32)
    s = s * (A_HEAD_DIM ** -0.5) + bias[:, None]
    s = jnp.where(valid[None, None, :, None, :], s, NEG_INF)
    p = jax.nn.softmax(s, axis=-1).astype(v.dtype)
    o = jnp.einsum('bhcqk,bckhd->bcqhd', p, vb)
    return o.reshape(bsz, seq, A_WIDTH)


def mla_attention(c_q, c_kv, k_rope, positions, rms_q, w_uq, rms_kv, w_ukv):
    bsz, seq = c_q.shape[0], c_q.shape[1]
    q = (rms_norm(c_q, rms_q) @ w_uq).reshape(bsz, seq, B_HEADS, B_QK_DIM)
    kv = (rms_norm(c_kv, rms_kv) @ w_ukv).reshape(bsz, seq, B_HEADS, B_NOPE_DIM + B_V_DIM)
    q_nope, q_pe = q[..., :B_NOPE_DIM], q[..., B_NOPE_DIM:]
    k_nope, v = kv[..., :B_NOPE_DIM], kv[..., B_NOPE_DIM:]
    q_pe = rope(q_pe, positions)
    k_pe = rope(k_rope[:, :, None, :], positions)
    q = jnp.concatenate([q_nope, q_pe], axis=-1)
    k = jnp.concatenate([k_nope, jnp.broadcast_to(k_pe, (bsz, seq, B_HEADS, B_ROPE_DIM))], axis=-1)
    n_qb = seq // Q_BLOCK
    qb = q.reshape(bsz, n_qb, Q_BLOCK, B_HEADS, B_QK_DIM).transpose(1, 0, 2, 3, 4)
    key_chunk = jnp.arange(seq) // CHUNK
    scale = B_QK_DIM ** -0.5

    def one_block(args):
        q_blk, start = args
        q_chunk = (start + jnp.arange(Q_BLOCK)) // CHUNK
        mask = key_chunk[None, :] <= q_chunk[:, None]
        s = jnp.einsum('bqhd,bkhd->bhqk', q_blk, k, preferred_element_type=jnp.float32) * scale
        s = jnp.where(mask[None, None], s, NEG_INF)
        p = jax.nn.softmax(s, axis=-1).astype(v.dtype)
        return jnp.einsum('bhqk,bkhd->bqhd', p, v)

    o = lax.map(one_block, (qb, jnp.arange(n_qb) * Q_BLOCK))
    return o.transpose(1, 0, 2, 3, 4).reshape(bsz, seq, B_WIDTH)


def moe_ffn(u, w_router, b_router, w_gate, b_gate, w_up, b_up, w_down, b_down):
    bsz, seq, d = u.shape
    n_tok = bsz * seq
    xt = u.reshape(n_tok, d)
    logits = jnp.dot(xt, w_router, preferred_element_type=jnp.float32) + b_router.astype(jnp.float32)
    top_val, top_idx = lax.top_k(logits, TOP_K)
    top_w = jax.nn.softmax(top_val, axis=-1)
    n_slots = n_tok * TOP_K
    slot_expert = top_idx.reshape(-1).astype(jnp.int32)
    slot_token = jnp.arange(n_slots, dtype=jnp.int32) // TOP_K
    slot_w = top_w.reshape(-1)
    order = jnp.argsort(slot_expert)
    sorted_expert = slot_expert[order]
    counts = jnp.bincount(slot_expert, length=N_EXPERTS)
    padded = ((counts + EXPERT_BLOCK - 1) // EXPERT_BLOCK) * EXPERT_BLOCK
    start = jnp.cumsum(counts) - counts
    pstart = jnp.cumsum(padded) - padded
    dest = pstart[sorted_expert] + jnp.arange(n_slots, dtype=jnp.int32) - start[sorted_expert]
    n_blocks = -(-n_slots // EXPERT_BLOCK) + N_EXPERTS
    cap = n_blocks * EXPERT_BLOCK
    buf_token = jnp.zeros((cap,), jnp.int32).at[dest].set(slot_token[order])
    buf_w = jnp.zeros((cap,), jnp.float32).at[dest].set(slot_w[order])
    block_start = jnp.arange(n_blocks, dtype=jnp.int32) * EXPERT_BLOCK
    block_expert = jnp.clip(jnp.searchsorted(jnp.cumsum(padded), block_start, side='right'), 0, N_EXPERTS - 1)

    def expert_block(args):
        tok, e = args
        xb = xt[tok]
        g = xb @ w_gate[e] + b_gate[e]
        up = xb @ w_up[e] + b_up[e]
        g = jnp.minimum(g, SWIGLU_LIMIT)
        up = jnp.clip(up, -SWIGLU_LIMIT, SWIGLU_LIMIT)
        h = (up + 1.0) * (g * jax.nn.sigmoid(SWIGLU_ALPHA * g))
        return h @ w_down[e] + b_down[e]

    y = lax.map(expert_block, (buf_token.reshape(n_blocks, EXPERT_BLOCK), block_expert))
    y = y.reshape(cap, d) * buf_w[:, None].astype(y.dtype)
    out = jnp.zeros((n_tok, d), u.dtype).at[buf_token].add(y)
    return out.reshape(bsz, seq, d)


def setup_inputs(seed: int = 0) -> dict:
    key = jax.random.key(seed)
    ks = jax.random.split(key, 26)

    def nrm(k, shape, scale):
        return jax.random.normal(k, shape, jnp.float32) * scale

    L, D, E, F = DEPTH, D_MODEL, N_EXPERTS, D_EXPERT
    positions = (jax.random.randint(ks[2], (BATCH, 1), 0, 4096, dtype=jnp.int32)
                 + jnp.arange(SEQ, dtype=jnp.int32)[None, :])
    return {
        "x": nrm(ks[0], (BATCH, SEQ, D), 1.0),
        "c": nrm(ks[1], (BATCH, D), 1.0),
        "positions": positions,
        "w_ada": nrm(ks[3], (L, D, 6 * D), 0.5 * D ** -0.5),
        "b_ada": nrm(ks[4], (L, 6 * D), 0.01),
        "w_in": nrm(ks[5], (L, D, N_IN), D ** -0.5),
        "rms_q": 1.0 + nrm(ks[6], (L, B_Q_LORA), 0.01),
        "w_uq": nrm(ks[7], (L, B_Q_LORA, B_HEADS * B_QK_DIM), B_Q_LORA ** -0.5),
        "rms_kv": 1.0 + nrm(ks[8], (L, B_KV_LORA), 0.01),
        "w_ukv": nrm(ks[9], (L, B_KV_LORA, B_HEADS * (B_NOPE_DIM + B_V_DIM)), B_KV_LORA ** -0.5),
        "rel_bias": nrm(ks[10], (L, A_HEADS, 2 * A_MAX_REL + 1), 0.5),
        "w_branch_a": nrm(ks[11], (L, A_WIDTH, D), DEEPNORM_BETA * A_WIDTH ** -0.5),
        "w_branch_b": nrm(ks[12], (L, B_WIDTH, D), DEEPNORM_BETA * B_WIDTH ** -0.5),
        "w_out": nrm(ks[13], (L, D, D), DEEPNORM_BETA * D ** -0.5),
        "ln1_g": 1.0 + nrm(ks[14], (L, D), 0.01),
        "ln1_b": nrm(ks[15], (L, D), 0.01),
        "w_router": nrm(ks[16], (L, D, E), D ** -0.5),
        "b_router": nrm(ks[17], (L, E), 0.01),
        "w_gate": nrm(ks[18], (L, E, D, F), D ** -0.5),
        "b_gate": nrm(ks[19], (L, E, F), 0.01),
        "w_up": nrm(ks[20], (L, E, D, F), D ** -0.5),
        "b_up": nrm(ks[21], (L, E, F), 0.01),
        "w_down": nrm(ks[22], (L, E, F, D), DEEPNORM_BETA * F ** -0.5),
        "b_down": nrm(ks[23], (L, E, D), 0.01),
        "ln2_g": 1.0 + nrm(ks[24], (L, D), 0.01),
        "ln2_b": nrm(ks[25], (L, D), 0.01),
    }


def reference(x, c, positions, w_ada, b_ada, w_in, rms_q, w_uq, rms_kv, w_ukv, rel_bias,
              w_branch_a, w_branch_b, w_out, ln1_g, ln1_b, w_router, b_router,
              w_gate, b_gate, w_up, b_up, w_down, b_down, ln2_g, ln2_b):
    bsz, seq = x.shape[0], x.shape[1]
    for l in range(DEPTH):
        mod = jnp.einsum('bd,dm->bm', jax.nn.silu(c), w_ada[l]) + b_ada[l]
        shift1, scale1, gate1, shift2, scale2, gate2 = jnp.split(mod[:, None, :], 6, axis=-1)

        h = x * (1.0 + scale1) + shift1
        z = h @ w_in[l]
        q_a, k_a, v_a, c_q, c_kv, k_rope, g_a, g_b = jnp.split(z, IN_SPLITS, axis=-1)
        y_a = chunked_relpos_attention(
            q_a.reshape(bsz, seq, A_HEADS, A_HEAD_DIM),
            k_a.reshape(bsz, seq, A_HEADS, A_HEAD_DIM),
            v_a.reshape(bsz, seq, A_HEADS, A_HEAD_DIM),
            rel_bias[l])
        y_b = mla_attention(c_q, c_kv, k_rope, positions, rms_q[l], w_uq[l], rms_kv[l], w_ukv[l])
        merged = (jax.nn.sigmoid(g_a) * (y_a @ w_branch_a[l])
                  + jax.nn.sigmoid(g_b) * (y_b @ w_branch_b[l]))
        x = layer_norm(DEEPNORM_ALPHA * x + gate1 * (merged @ w_out[l]), ln1_g[l], ln1_b[l])

        h = x * (1.0 + scale2) + shift2
        f = moe_ffn(h, w_router[l], b_router[l], w_gate[l], b_gate[l], w_up[l], b_up[l], w_down[l], b_down[l])
        x = layer_norm(DEEPNORM_ALPHA * x + gate2 * f, ln2_g[l], ln2_b[l])
    return x
```

```cpp
#include <hip/hip_runtime.h>
#include <cstdio>
#include <cstdint>
namespace pg8 {
#define PG8_LAS __attribute__((address_space(3)))
typedef unsigned short bf16_t;
typedef short bf16x8 __attribute__((ext_vector_type(8)));
typedef float f32x4 __attribute__((ext_vector_type(4)));
typedef unsigned u32x4 __attribute__((ext_vector_type(4)));
typedef unsigned u32x2 __attribute__((ext_vector_type(2)));
constexpr int BM = 256, BK = 64, HALF = 128, HTB = HALF * BK * 2, STAGE_BYTES = 8 * HTB, NXCD = 8, WGM = 8;

__host__ __device__ __forceinline__ int lds_byte(int r, int c) { const int st = (r >> 4) * 2 + (c >> 5), rr = r & 15, cc = c & 31, ob = rr * 64 + cc * 2; return st * 1024 + (ob ^ (((ob >> 9) & 1) << 5)); }
__host__ __device__ __forceinline__ void stage_rc(int b, int& R, int& C) { const int st = b / 1024, sb = b % 1024, swz = sb ^ (((sb >> 9) & 1) << 5); R = (st >> 1) * 16 + swz / 64; C = (st & 1) * 32 + (swz % 64) / 2; }
__host__ __device__ __forceinline__ int perm32(int rho) { const int n = rho >> 4, i = rho & 15; return 8 * (i >> 2) + 4 * n + (i & 3); }

struct Unit { const char* A; const char* B; int pm, pn, x0, x1, x2, slot; };

struct StaticOrder {
    const char* A; const char* B; int K; int nM, nN, nwg, G, c;
    __device__ void init(const void* A_, const void* B_, int M, int N, int K_, int G_, int c_) { A = (const char*)A_; B = (const char*)B_; K = K_; nM = M / BM; nN = N / BM; nwg = nM * nN; G = G_; c = c_; }
    __device__ bool next(int i, Unit& u) const {
        const long L = (long)i * G + c; if (L >= nwg) return false;
        int wgid = (int)L; { const int q = nwg / NXCD, r = nwg % NXCD, xcd = wgid % NXCD, off = wgid / NXCD; wgid = (xcd < r ? xcd * (q + 1) : r * (q + 1) + (xcd - r) * q) + off; }
        const int nig = WGM * nN, gid = wgid / nig, fm = gid * WGM, gsz = (nM - fm) < WGM ? (nM - fm) : WGM;
        u.pm = fm + ((wgid % nig) % gsz); u.pn = (wgid % nig) / gsz;
        u.A = A + (size_t)u.pm * BM * K * 2; u.B = B + (size_t)u.pn * BM * K * 2; u.x0 = 0; u.x1 = 0; u.x2 = 0; u.slot = 0; return true;
    }
    __device__ __forceinline__ unsigned goff(int, int) const { return 0u; }
};

__device__ __forceinline__ unsigned cvt_pk_bf16(float lo, float hi) { unsigned r; asm volatile("v_cvt_pk_bf16_f32 %0, %1, %2" : "=v"(r) : "v"(lo), "v"(hi)); return r; }
__device__ __forceinline__ float bf_lo(unsigned w) { return __uint_as_float(w << 16); }
__device__ __forceinline__ float bf_hi(unsigned w) { return __uint_as_float(w & 0xffff0000u); }

template <class Epi, class Sched, bool ALIGN_EPI, bool GATHER>
__device__ __forceinline__ void gemm_phase(PG8_LAS unsigned char* lds, const int K, const Sched& S, const Epi& E) {
    int tid_o = threadIdx.x; asm volatile("" : "+v"(tid_o));
    const int tid = tid_o, wid = __builtin_amdgcn_readfirstlane(tid >> 6), lane = tid & 63, wr = wid >> 2, wc = wid & 3, fr = lane & 15, fq = lane >> 4;
    const int nt = K / BK;
    unsigned voffA[2], voffB[2]; int RA[2]; unsigned CA2[2];
#pragma unroll
    for (int i = 0; i < 2; ++i) { int R, C; stage_rc(tid * 16 + i * 8192, R, C); const int Rb = Epi::PERM ? ((R & ~31) + perm32(R & 31)) : R;
        voffA[i] = (unsigned)(R * K + C) * 2u; voffB[i] = (unsigned)(Rb * K + C) * 2u; RA[i] = R; CA2[i] = (unsigned)C * 2u; }
    const size_t kstep = (size_t)(BK * 2);
    const size_t hstep = (size_t)HALF * K * 2;
    const unsigned ldsw = (unsigned)wid * 1024u;
    const int aoff = lds_byte(wr * 64 + fr, fq * 8), boff = lds_byte(wc * 32 + fr, fq * 8);
#define PG8_SA(b, h) (((b) * 2 + (h)) * HTB)
#define PG8_SB(b, h) ((4 + (b) * 2 + (h)) * HTB)
#define PG8_STAGE(bufoff, gbase, voff) do { _Pragma("unroll") for (int _i = 0; _i < 2; ++_i) \
        __builtin_amdgcn_global_load_lds((const unsigned*)((const char*)(gbase) + (voff)[_i]), (PG8_LAS unsigned*)(lds + (bufoff) + ldsw + _i * 8192), 16, 0, 0); } while (0)
#define PG8_STAGE_A(bufoff, gbase, h, nx) do { if constexpr (GATHER) { unsigned _v[2]; _v[0] = (nx) ? gAn[h][0] : gAc[h][0]; _v[1] = (nx) ? gAn[h][1] : gAc[h][1]; PG8_STAGE(bufoff, gbase, _v); } \
        else { PG8_STAGE(bufoff, (gbase) + (h) * hstep, voffA); } } while (0)
#define PG8_LDA(dst, b, h) do { _Pragma("unroll") for (int m = 0; m < 4; ++m) _Pragma("unroll") for (int k = 0; k < 2; ++k) dst[m][k] = *(const PG8_LAS bf16x8*)(lds + PG8_SA(b, h) + aoff + m * 2048 + k * 1024); } while (0)
#define PG8_LDB(dst, b, h) do { _Pragma("unroll") for (int n = 0; n < 2; ++n) _Pragma("unroll") for (int k = 0; k < 2; ++k) dst[n][k] = *(const PG8_LAS bf16x8*)(lds + PG8_SB(b, h) + boff + n * 2048 + k * 1024); } while (0)
#define PG8_MMA(ai, bj, At, Bt) do { __builtin_amdgcn_s_setprio(1); _Pragma("unroll") for (int m = 0; m < 4; ++m) _Pragma("unroll") for (int n = 0; n < 2; ++n) _Pragma("unroll") for (int k = 0; k < 2; ++k) \
        acc[ai][bj][m][n] = __builtin_amdgcn_mfma_f32_16x16x32_bf16(Bt[n][k], At[m][k], acc[ai][bj][m][n], 0, 0, 0); __builtin_amdgcn_s_setprio(0); } while (0)
#define PG8_WAIT_V(n) asm volatile("s_waitcnt vmcnt(" #n ")" ::: "memory")
#define PG8_WAIT_L(n) asm volatile("s_waitcnt lgkmcnt(" #n ")" ::: "memory")
#define PG8_BAR __builtin_amdgcn_s_barrier()
#define PG8_SCHED __builtin_amdgcn_sched_barrier(0)
    Unit cur, nxt; int ui = 0;
    if (!S.next(0, cur)) return;
    unsigned gAc[2][2], gAn[2][2];
    if constexpr (GATHER) {
#pragma unroll
        for (int h = 0; h < 2; ++h)
#pragma unroll
            for (int i = 0; i < 2; ++i) { gAc[h][i] = S.goff(cur.slot, h * HALF + RA[i]) + CA2[i]; gAn[h][i] = gAc[h][i]; }
    }
    f32x4 acc[2][2][4][2];
#pragma unroll
    for (int a = 0; a < 2; ++a)
#pragma unroll
        for (int b = 0; b < 2; ++b)
#pragma unroll
            for (int m = 0; m < 4; ++m)
#pragma unroll
                for (int n = 0; n < 2; ++n) acc[a][b][m][n] = (f32x4){0.f, 0.f, 0.f, 0.f};
    bf16x8 At[4][2], B0[2][2], B1[2][2];
    const char* cA = cur.A; const char* cB = cur.B;
    PG8_STAGE(PG8_SB(0, 0), cB, voffB); PG8_STAGE(PG8_SB(0, 1), cB + hstep, voffB); PG8_STAGE_A(PG8_SA(0, 0), cA, 0, false); PG8_STAGE_A(PG8_SA(0, 1), cA, 1, false);
    if (wr == 1) PG8_BAR;
    PG8_WAIT_V(2); PG8_BAR;
    PG8_STAGE(PG8_SB(1, 0), cB + kstep, voffB); PG8_STAGE_A(PG8_SA(1, 0), cA + kstep, 0, false); PG8_STAGE(PG8_SB(1, 1), cB + hstep + kstep, voffB);
    PG8_WAIT_V(6); PG8_BAR;
    for (;;) {
        const bool has_next = S.next(ui + 1, nxt);
        const char* nA = has_next ? nxt.A : cA; const char* nB = has_next ? nxt.B : cB;
        if constexpr (GATHER) {
            if (has_next) {
#pragma unroll
                for (int h = 0; h < 2; ++h)
#pragma unroll
                    for (int i = 0; i < 2; ++i) gAn[h][i] = S.goff(nxt.slot, h * HALF + RA[i]) + CA2[i];
            } else {
#pragma unroll
                for (int h = 0; h < 2; ++h)
#pragma unroll
                    for (int i = 0; i < 2; ++i) gAn[h][i] = gAc[h][i];
            }
        }
        for (int t = 0; t < nt; t += 2) {
            const bool last = (t == nt - 2);
            const char* a1 = cA + (size_t)(t + 1) * kstep;
            const char* a2 = last ? nA : cA + (size_t)(t + 2) * kstep; const char* b2 = last ? nB : cB + (size_t)(t + 2) * kstep;
            const char* a3 = a2 + kstep; const char* b3 = b2 + kstep;
            PG8_LDB(B0, 0, 0); PG8_LDB(B1, 0, 1); PG8_SCHED; PG8_LDA(At, 0, 0); PG8_STAGE_A(PG8_SA(1, 1), a1, 1, false);
            PG8_WAIT_V(8); PG8_WAIT_L(0); PG8_BAR; PG8_MMA(0, 0, At, B0); PG8_MMA(0, 1, At, B1); PG8_BAR; PG8_SCHED;
            PG8_LDA(At, 0, 1); PG8_STAGE(PG8_SB(0, 0), b2, voffB); PG8_STAGE(PG8_SB(0, 1), b2 + hstep, voffB); PG8_STAGE_A(PG8_SA(0, 0), a2, 0, last);
            PG8_WAIT_V(8); PG8_WAIT_L(0); PG8_BAR; PG8_MMA(1, 0, At, B0); PG8_MMA(1, 1, At, B1); PG8_BAR; PG8_SCHED;
            PG8_LDB(B0, 1, 0); PG8_LDB(B1, 1, 1); PG8_SCHED; PG8_LDA(At, 1, 0); PG8_STAGE_A(PG8_SA(0, 1), a2, 1, last);
            PG8_WAIT_V(8); PG8_WAIT_L(0); PG8_BAR; PG8_MMA(0, 0, At, B0); PG8_MMA(0, 1, At, B1); PG8_BAR; PG8_SCHED;
            PG8_LDA(At, 1, 1); PG8_STAGE(PG8_SB(1, 0), b3, voffB); PG8_STAGE(PG8_SB(1, 1), b3 + hstep, voffB); PG8_STAGE_A(PG8_SA(1, 0), a3, 0, last);
            PG8_WAIT_V(8); PG8_WAIT_L(0); PG8_BAR; PG8_MMA(1, 0, At, B0); PG8_MMA(1, 1, At, B1); PG8_BAR; PG8_SCHED;
        }
        if constexpr (ALIGN_EPI) { if (wr == 0) PG8_BAR; }
        { int lo_ = lane; asm volatile("" : "+v"(lo_)); E(acc, cur, wr, wc, lo_ & 15, lo_ >> 4); }
        if (!has_next) break;
#pragma unroll
        for (int a = 0; a < 2; ++a)
#pragma unroll
            for (int b = 0; b < 2; ++b)
#pragma unroll
                for (int m = 0; m < 4; ++m)
#pragma unroll
                    for (int n = 0; n < 2; ++n) acc[a][b][m][n] = (f32x4){0.f, 0.f, 0.f, 0.f};
        cur = nxt; cA = nA; cB = nB; ++ui;
        if constexpr (GATHER) {
#pragma unroll
            for (int h = 0; h < 2; ++h)
#pragma unroll
                for (int i = 0; i < 2; ++i) gAc[h][i] = gAn[h][i];
        }
        if constexpr (ALIGN_EPI) { if (wr == 1) PG8_BAR; }
    }
    PG8_WAIT_V(0);
    if constexpr (!ALIGN_EPI) { if (wr == 0) PG8_BAR; }
    PG8_BAR;
#undef PG8_SA
#undef PG8_SB
#undef PG8_STAGE
#undef PG8_STAGE_A
#undef PG8_LDA
#undef PG8_LDB
#undef PG8_MMA
#undef PG8_WAIT_V
#undef PG8_WAIT_L
#undef PG8_BAR
#undef PG8_SCHED
}
}
namespace fk {
using pg8::bf16_t; using pg8::bf16x8; using pg8::f32x4; using pg8::u32x4; using pg8::u32x2; using pg8::Unit; using pg8::cvt_pk_bf16; using pg8::bf_lo; using pg8::bf_hi;
#define LAS __attribute__((address_space(3)))
typedef float f32x16 __attribute__((ext_vector_type(16)));
typedef float f32x2 __attribute__((ext_vector_type(2)));
typedef short s16x4 __attribute__((ext_vector_type(4)));
constexpr int T = 16384, D = 1024, S = 2048, NB = 8, NE = 32, NIN = 4256;
constexpr int NWAVES = 8, NTHR = 512;
constexpr float ALPHA = 1.189207115002721f, LOG2E = 1.4426950408889634f;
constexpr float QA_SCALE = 0.125f * LOG2E;
constexpr float QB_SCALE = 0.10206207261596575f * LOG2E;

constexpr size_t MiB = 1u << 20;
constexpr size_t WS_CTL = 0, CTL_ZERO_BYTES = 1 * MiB;
constexpr size_t WS_MODP = 1 * MiB, WS_MOD = 4 * MiB, WS_CS = 5 * MiB, WS_SSQQ = 7 * MiB, WS_SSQKV = 7 * MiB + 512 * 1024;
constexpr size_t WS_TE = 8 * MiB, WS_TW = 8 * MiB + 256 * 1024, WS_TP = 8 * MiB + 512 * 1024, WS_LISTS = 9 * MiB;
constexpr size_t WS_WIN = 12 * MiB, WS_WUQ = 21 * MiB, WS_WUKV = 22 * MiB, WS_WBA = 23 * MiB, WS_WBB = 24 * MiB, WS_WOUT = 25 * MiB;
constexpr size_t WS_WGU = 28 * MiB, WS_WD = 156 * MiB;
constexpr size_t WS_H1 = 220 * MiB, WS_QA = 252 * MiB, WS_KA = 268 * MiB, WS_VA = 284 * MiB, WS_CQ = 300 * MiB, WS_CKV = 312 * MiB, WS_KPE = 320 * MiB, WS_GA = 321 * MiB, WS_GB = 353 * MiB;
constexpr size_t WS_QB = 220 * MiB, WS_KB = 385 * MiB, WS_VB = 401 * MiB, WS_YA = 417 * MiB, WS_YB = 433 * MiB, WS_MG = 252 * MiB, WS_H2 = 353 * MiB, WS_HE = 220 * MiB, WS_YE = 28 * MiB;
constexpr size_t WS_END = 449 * MiB;
constexpr int NPAD_WIN = 4352;
constexpr int CW_BAR = 4096, CW_CNT = 8192;
constexpr int RING_BYTES = 131072, LDSX = RING_BYTES, LDS_BYTES = 147456;
constexpr int LX_MISC = LDSX, LX_CNT = LDSX + 256, LX_BASE = LDSX + 512, LX_BPRE = LDSX + 768, LX_NLOC = LDSX + 1024, LX_UTAB = LDSX + 1280, LX_GTAB = LDSX + 2048;

#define LDS_WAIT() asm volatile("s_waitcnt lgkmcnt(0)" ::: "memory")
#define VM_WAIT() asm volatile("s_waitcnt vmcnt(0)" ::: "memory")

#define XB_TMO      128
#define XB_XCNT(j)  (256  + 64 * (j))
#define XB_XSUB(j)  (1280 + 64 * (j))
#define XB_XGEN(j)  (2304 + 64 * (j))
#define XB_TOP      3328
#define XB_TOPGEN   3392
#define XCD_BAR_WORDS 3456
#define XB_SPIN_CAP (1u << 18)
__device__ __forceinline__ unsigned xb_ld(unsigned* p)              { return __hip_atomic_load(p, __ATOMIC_RELAXED, __HIP_MEMORY_SCOPE_AGENT); }
__device__ __forceinline__ unsigned xb_add(unsigned* p, unsigned v) { return __hip_atomic_fetch_add(p, v, __ATOMIC_RELAXED, __HIP_MEMORY_SCOPE_AGENT); }
__device__ __forceinline__ unsigned xb_xcc_id() { return (unsigned)__builtin_amdgcn_s_getreg((3 << 11) | 20) & 0xFu; }
#define XB_SPIN(cond, bar) do { unsigned _sp = 0; while (cond) { __builtin_amdgcn_s_sleep(1); \
    if ((++_sp & 255u) == 0u) { if (xb_ld(&(bar)[XB_TMO])) break; if (_sp > XB_SPIN_CAP) { atomicAdd(&(bar)[XB_TMO], 1u); break; } } } } while (0)
struct XcdBarrier { unsigned* bar; unsigned x; volatile LAS unsigned* st; };
__device__ __forceinline__ XcdBarrier xcd_barrier_post(unsigned* bar, volatile LAS unsigned* st) {
    XcdBarrier b; b.bar = bar; b.x = xb_xcc_id(); b.st = st;
    if (threadIdx.x == 0) (void)xb_add(&bar[XB_XCNT(b.x)], 1u);
    return b;
}
__device__ __forceinline__ void xcd_barrier_complete(unsigned* bar, unsigned x, unsigned& nloc, unsigned& nx) {
    const unsigned G = gridDim.x * gridDim.y * gridDim.z;
    unsigned sum, cnt, mine, sp = 0u;
    for (;;) {
        sum = 0u; cnt = 0u; mine = 0u;
#pragma unroll
        for (unsigned j = 0; j < 16; ++j) { const unsigned c = xb_ld(&bar[XB_XCNT(j)]); sum += c; cnt += (c > 0u) ? 1u : 0u; mine = (j == x) ? c : mine; }
        if (sum == G) break;
        __builtin_amdgcn_s_sleep(1);
        if ((++sp & 255u) == 0u) { if (xb_ld(&bar[XB_TMO])) break; if (sp > XB_SPIN_CAP) { atomicAdd(&bar[XB_TMO], 1u); break; } }
    }
    nloc = mine > 0u ? mine : 1u; nx = cnt > 0u ? cnt : 1u;
}
__device__ __forceinline__ void xcd_barrier(const XcdBarrier& b) {
    asm volatile("s_waitcnt vmcnt(0)" ::: "memory");
    __syncthreads();
    if (threadIdx.x == 0) {
        unsigned* bar = b.bar;
        __builtin_amdgcn_s_waitcnt(0);
        unsigned nloc = b.st[0], nx = b.st[1];
        if (nloc == 0u) { xcd_barrier_complete(bar, b.x, nloc, nx); b.st[0] = nloc; b.st[1] = nx; }
        const unsigned old = xb_add(&bar[XB_XSUB(b.x)], 1u);
        const unsigned gen = old / nloc;
        if (old + 1u == (gen + 1u) * nloc) {
            __builtin_amdgcn_fence(__ATOMIC_RELEASE, "agent");
            asm volatile("s_waitcnt vmcnt(0)" ::: "memory");
            const unsigned og = xb_add(&bar[XB_TOP], 1u);
            const unsigned tg = og / nx;
            if (og + 1u == (tg + 1u) * nx) xb_add(&bar[XB_TOPGEN], 1u);
            else XB_SPIN(xb_ld(&bar[XB_TOPGEN]) == tg, bar);
            __builtin_amdgcn_fence(__ATOMIC_ACQUIRE, "agent");
            xb_add(&bar[XB_XGEN(b.x)], 1u);
            asm volatile("s_waitcnt vmcnt(0)" ::: "memory");
        } else {
            XB_SPIN(xb_ld(&bar[XB_XGEN(b.x)]) == gen, bar);
            __builtin_amdgcn_fence(__ATOMIC_ACQUIRE, "agent");
            asm volatile("s_waitcnt vmcnt(0)" ::: "memory");
        }
    }
    __syncthreads();
}

struct KP { const float* in[26]; float* out; unsigned char* ws; int ph_lo, ph_hi; };

struct Frame {
    LAS unsigned char* lds; int tid, lane, wave, G, bx;
    const float *x, *c, *w_ada, *b_ada, *w_in, *rms_q, *w_uq, *rms_kv, *w_ukv, *rel_bias, *wba, *wbb, *w_out, *ln1_g, *ln1_b, *w_router, *b_router, *w_gate, *b_gate, *w_up, *b_up, *w_down, *b_down, *ln2_g, *ln2_b;
    const int* pos; float* out; unsigned char* ws;
};
__device__ __forceinline__ float wave_sum(float v) {
#pragma unroll
    for (int o = 1; o < 64; o <<= 1) v += __shfl_xor(v, o);
    return v;
}
__device__ __forceinline__ float fast_sigmoid(float x) { return __builtin_amdgcn_rcpf(1.f + __builtin_amdgcn_exp2f(-LOG2E * x)); }

template <class MapF>
__device__ __forceinline__ void transpose_item(const float* __restrict__ W, int K, int N, bf16_t* __restrict__ WT, MapF F, const float* __restrict__ kscale, LAS float* scr, int item, int lane) {
    const int nblk = N / 32, kb = item / nblk, nb = item % nblk, k0 = 64 * kb, n0 = 32 * nb;
#pragma unroll 8
    for (int i = 0; i < 32; ++i) { const int kk = 2 * i + (lane >> 5); float v = W[(size_t)(k0 + kk) * N + n0 + (lane & 31)]; if (kscale) v *= kscale[k0 + kk]; scr[kk * 33 + (lane & 31)] = v; }
    LDS_WAIT(); asm volatile("" ::: "memory");
    const int c = lane & 7;
#pragma unroll
    for (int j = 0; j < 4; ++j) { const int n = (lane >> 3) + 8 * j; const LAS float* s = scr + (8 * c) * 33 + n;
        u32x4 o; o.x = cvt_pk_bf16(s[0 * 33], s[1 * 33]); o.y = cvt_pk_bf16(s[2 * 33], s[3 * 33]); o.z = cvt_pk_bf16(s[4 * 33], s[5 * 33]); o.w = cvt_pk_bf16(s[6 * 33], s[7 * 33]);
        *(u32x4*)(WT + (size_t)F(n0 + n) * K + k0 + 8 * c) = o; }
    LDS_WAIT(); asm volatile("" ::: "memory");
}
struct MapId { __device__ int operator()(int n) const { return n; } };
struct MapWin { __device__ int operator()(int n) const {
    if (n < 1920) return n;
    if (n < 2176) return 2048 + (n - 1920);
    if (n < 2208) { const int i = n - 2176; return 1920 + 8 * ((i & 15) >> 2) + 4 * (i >> 4) + (i & 3); }
    if (n < 3232) return 2304 + (n - 2208);
    return 3328 + (n - 3232); } };
struct MapUq { __device__ int operator()(int n) const { const int h = n / 96, j = n - h * 96; return j < 64 ? h * 64 + j : 512 + h * 32 + (j - 64); } };
struct MapUkv { __device__ int operator()(int n) const { const int h = n >> 7, j = n & 127; return j < 64 ? h * 64 + j : 512 + h * 64 + (j - 64); } };
struct MapGU { int up; __device__ int operator()(int n) const { return 256 * (n >> 7) + (up ? 128 : 0) + (n & 127); } };

__device__ __forceinline__ void rope_cs(int pos, int i, float& cs, float& sn) {
    const double b4 = (i & 3) == 0 ? 1.0 : (i & 3) == 1 ? 0.5623413251903491 : (i & 3) == 2 ? 0.31622776601683794 : 0.17782794100389228;
    const double p10 = (i >> 2) == 0 ? 1.0 : (i >> 2) == 1 ? 0.1 : (i >> 2) == 2 ? 0.01 : 0.001;
    double t = (double)pos * (b4 * p10) * 0.15915494309189535;
    t -= __builtin_rint(t);
    const float tf = (float)t;
    sn = __builtin_amdgcn_sinf(tf); cs = __builtin_amdgcn_cosf(tf);
}

__device__ __forceinline__ void p0_prologue(Frame& F) {
    const int gw = F.bx * NWAVES + F.wave, NGW = F.G * NWAVES, lane = F.lane;
    float* modp = (float*)(F.ws + WS_MODP);
    for (int it = gw; it < 96 * 16; it += NGW) {
        const int cg = it % 96, ks = it / 96, m = cg * 64 + lane;
        float sc[8], acc[8];
#pragma unroll
        for (int b = 0; b < 8; ++b) { const float cv = F.c[b * D + ks * 64 + lane]; sc[b] = cv / (1.f + __expf(-cv)); acc[b] = 0.f; }
#pragma unroll 8
        for (int kk = 0; kk < 64; ++kk) { const float w = F.w_ada[(size_t)(ks * 64 + kk) * 6144 + m];
#pragma unroll
            for (int b = 0; b < 8; ++b) acc[b] += __int_as_float(__builtin_amdgcn_readlane(__float_as_int(sc[b]), kk)) * w; }
#pragma unroll
        for (int b = 0; b < 8; ++b) modp[(size_t)(ks * 8 + b) * 6144 + m] = acc[b];
    }
    LAS float* scr = (LAS float*)(F.lds + F.wave * 16384);
    constexpr int I_EXP = 32 * 3 * 512, I_WIN = 16 * 133, I_WUQ = 6 * 24, I_WUKV = 4 * 32, I_WB = 8 * 32, I_WOUT = 16 * 32;
    constexpr int NITEMS = I_EXP + I_WIN + I_WUQ + I_WUKV + 2 * I_WB + I_WOUT;
    for (int it = gw; it < NITEMS; it += NGW) {
        int r = it;
        if (r < I_EXP) { const int e = r / 1536, q = r % 1536, mat = q / 512, item = q % 512;
            if (mat == 0) { MapGU mp{0}; transpose_item(F.w_gate + (size_t)e * D * D, D, D, (bf16_t*)(F.ws + WS_WGU) + (size_t)e * 2048 * D, mp, nullptr, scr, item, lane); }
            else if (mat == 1) { MapGU mp{1}; transpose_item(F.w_up + (size_t)e * D * D, D, D, (bf16_t*)(F.ws + WS_WGU) + (size_t)e * 2048 * D, mp, nullptr, scr, item, lane); }
            else transpose_item(F.w_down + (size_t)e * D * D, D, D, (bf16_t*)(F.ws + WS_WD) + (size_t)e * D * D, MapId(), nullptr, scr, item, lane);
            continue; } r -= I_EXP;
        if (r < I_WIN) { transpose_item(F.w_in, D, NIN, (bf16_t*)(F.ws + WS_WIN), MapWin(), nullptr, scr, r, lane); continue; } r -= I_WIN;
        if (r < I_WUQ) { transpose_item(F.w_uq, 384, 768, (bf16_t*)(F.ws + WS_WUQ), MapUq(), F.rms_q, scr, r, lane); continue; } r -= I_WUQ;
        if (r < I_WUKV) { transpose_item(F.w_ukv, 256, 1024, (bf16_t*)(F.ws + WS_WUKV), MapUkv(), F.rms_kv, scr, r, lane); continue; } r -= I_WUKV;
        if (r < I_WB) { transpose_item(F.wba, 512, D, (bf16_t*)(F.ws + WS_WBA), MapId(), nullptr, scr, r, lane); continue; } r -= I_WB;
        if (r < I_WB) { transpose_item(F.wbb, 512, D, (bf16_t*)(F.ws + WS_WBB), MapId(), nullptr, scr, r, lane); continue; } r -= I_WB;
        transpose_item(F.w_out, D, D, (bf16_t*)(F.ws + WS_WOUT), MapId(), nullptr, scr, r, lane);
    }
    const int gt = F.bx * NTHR + F.tid, NGT = F.G * NTHR;
    f32x2* cs = (f32x2*)(F.ws + WS_CS);
    for (int i = gt; i < T * 16; i += NGT) { float c_, s_; rope_cs(F.pos[i >> 4], i & 15, c_, s_); cs[i] = (f32x2){c_, s_}; }
    u32x4* padp = (u32x4*)((bf16_t*)(F.ws + WS_WIN) + (size_t)1952 * D);
    for (int i = gt; i < 96 * D * 2 / 16; i += NGT) padp[i] = (u32x4){0u, 0u, 0u, 0u};
}

__device__ __forceinline__ void p1_h1(Frame& F) {
    const float* modp = (const float*)(F.ws + WS_MODP); float* mod = (float*)(F.ws + WS_MOD);
    for (int i = F.bx * NTHR + F.tid; i < 8 * 6144; i += F.G * NTHR) { const int m = i % 6144; float a = F.b_ada[m];
#pragma unroll
        for (int ks = 0; ks < 16; ++ks) a += modp[(size_t)ks * 8 * 6144 + i];
        mod[i] = a; }
    LAS float* sh = (LAS float*)F.lds; LAS float* sc = sh + 1024;
    bf16_t* H1 = (bf16_t*)(F.ws + WS_H1);
    for (int blk = F.bx; blk < T / 64; blk += F.G) {
        const int b = (blk * 64) / S;
        __syncthreads();
        for (int i = F.tid; i < 2048; i += NTHR) { float a = F.b_ada[i];
#pragma unroll
            for (int ks = 0; ks < 16; ++ks) a += modp[(size_t)(ks * 8 + b) * 6144 + i];
            sh[i] = a; }
        __syncthreads();
        for (int rr = F.wave; rr < 64; rr += NWAVES) {
            const int row = blk * 64 + rr;
            const f32x4* xr = (const f32x4*)(F.x + (size_t)row * D) + F.lane; u32x2* o = (u32x2*)(H1 + (size_t)row * D) + F.lane;
#pragma unroll
            for (int j = 0; j < 4; ++j) { const f32x4 v = xr[64 * j]; const int k = 4 * F.lane + 256 * j;
                const f32x4 s1 = *(const LAS f32x4*)(sh + k), c1 = *(const LAS f32x4*)(sc + k);
                u32x2 w; w.x = cvt_pk_bf16(v.x * (1.f + c1.x) + s1.x, v.y * (1.f + c1.y) + s1.y); w.y = cvt_pk_bf16(v.z * (1.f + c1.z) + s1.z, v.w * (1.f + c1.w) + s1.w); o[64 * j] = w; }
        }
    }
}
typedef f32x4 Acc[2][2][4][2];
__device__ __forceinline__ u32x4 pack8(const f32x4 a, const f32x4 b) { u32x4 w; w.x = cvt_pk_bf16(a[0], a[1]); w.y = cvt_pk_bf16(a[2], a[3]); w.z = cvt_pk_bf16(b[0], b[1]); w.w = cvt_pk_bf16(b[2], b[3]); return w; }
__device__ __forceinline__ size_t kimg_idx(int r, int h, int chunk) { const int b = r >> 11, s = r & 2047; return ((size_t)((b * 8 + h) * 32 + (s >> 6)) * 4096) + chunk * 512 + (s & 63) * 8; }
__device__ __forceinline__ size_t vimg_idx(int r, int h, int g) { const int b = r >> 11, s = r & 2047, key = s & 63; return ((size_t)((b * 8 + h) * 32 + (s >> 6)) * 4096) + (g >> 2) * 2048 + (key >> 3) * 256 + (key & 7) * 32 + (g & 3) * 8; }
__device__ __forceinline__ size_t kpe_idx(int r, int chunk) { const int b = r >> 11, s = r & 2047; return ((size_t)(b * 32 + (s >> 6)) * 2048) + chunk * 512 + (s & 63) * 8; }

struct EpiZ {
    static constexpr bool PERM = true;
    bf16_t *QA, *KA, *VA, *CQ, *CKV, *KPE, *GA, *GB; float *SSQQ, *SSQKV; const f32x2* cs;
    __device__ __forceinline__ void operator()(const Acc& acc, const Unit& u, int wr, int wc, int fr, int fq) const {
        const int pn = u.pn, row0 = u.pm * 256 + wr * 64 + fr;
#pragma unroll
        for (int ai = 0; ai < 2; ++ai)
#pragma unroll
            for (int m = 0; m < 4; ++m) {
                const int r = row0 + ai * 128 + m * 16;
                if (pn < 2) {
#pragma unroll
                    for (int bj = 0; bj < 2; ++bj) { const int c = pn * 256 + bj * 128 + wc * 32 + 8 * fq;
                        *(u32x4*)(QA + (size_t)r * 512 + c) = pack8(acc[ai][bj][m][0] * QA_SCALE, acc[ai][bj][m][1] * QA_SCALE); }
                } else if (pn < 4) {
#pragma unroll
                    for (int bj = 0; bj < 2; ++bj) { const int c = (pn - 2) * 256 + bj * 128 + wc * 32 + 8 * fq;
                        *(u32x4*)(KA + kimg_idx(r, c >> 6, (c & 63) >> 3)) = pack8(acc[ai][bj][m][0], acc[ai][bj][m][1]); }
                } else if (pn < 6) {
#pragma unroll
                    for (int bj = 0; bj < 2; ++bj) { const int c = (pn - 4) * 256 + bj * 128 + wc * 32 + 8 * fq;
                        *(u32x4*)(VA + vimg_idx(r, c >> 6, (c & 63) >> 3)) = pack8(acc[ai][bj][m][0], acc[ai][bj][m][1]); }
                } else if (pn == 6 || pn == 8) {
                    float s = 0.f;
#pragma unroll
                    for (int bj = 0; bj < 2; ++bj) { const int c = bj * 128 + wc * 32 + 8 * fq; const f32x4 a = acc[ai][bj][m][0], b = acc[ai][bj][m][1];
                        s += (a[0] * a[0] + a[1] * a[1]) + (a[2] * a[2] + a[3] * a[3]) + (b[0] * b[0] + b[1] * b[1]) + (b[2] * b[2] + b[3] * b[3]);
                        if (pn == 6) *(u32x4*)(CQ + (size_t)r * 384 + c) = pack8(a, b); else *(u32x4*)(CKV + (size_t)r * 256 + c) = pack8(a, b); }
                    s += __shfl_xor(s, 16); s += __shfl_xor(s, 32);
                    if (fq == 0) { if (pn == 6) SSQQ[(size_t)r * 8 + wc] = s; else SSQKV[(size_t)r * 4 + wc] = s; }
                } else if (pn == 7) {
                    { const int c = wc * 32 + 8 * fq; const f32x4 a = acc[ai][0][m][0], b = acc[ai][0][m][1];
                      float s = (a[0] * a[0] + a[1] * a[1]) + (a[2] * a[2] + a[3] * a[3]) + (b[0] * b[0] + b[1] * b[1]) + (b[2] * b[2] + b[3] * b[3]);
                      *(u32x4*)(CQ + (size_t)r * 384 + 256 + c) = pack8(a, b);
                      s += __shfl_xor(s, 16); s += __shfl_xor(s, 32);
                      if (fq == 0) SSQQ[(size_t)r * 8 + 4 + wc] = s; }
                    if (wc == 0) {
                        const f32x4 x1 = acc[ai][1][m][0], x2 = acc[ai][1][m][1]; f32x4 o1, o2;
#pragma unroll
                        for (int j = 0; j < 4; ++j) { const f32x2 c_ = cs[(size_t)r * 16 + 4 * fq + j]; o1[j] = x1[j] * c_.x - x2[j] * c_.y; o2[j] = x2[j] * c_.x + x1[j] * c_.y; }
                        *(u32x4*)(KPE + kpe_idx(r, fq)) = pack8(o1, o2);
                    }
                } else {
                    bf16_t* G = pn < 13 ? GA : GB; const int cb = (pn < 13 ? pn - 9 : pn - 13) * 256;
#pragma unroll
                    for (int bj = 0; bj < 2; ++bj) { const int c = cb + bj * 128 + wc * 32 + 8 * fq; f32x4 a = acc[ai][bj][m][0], b = acc[ai][bj][m][1];
#pragma unroll
                        for (int j = 0; j < 4; ++j) { a[j] = fast_sigmoid(a[j]); b[j] = fast_sigmoid(b[j]); }
                        *(u32x4*)(G + (size_t)r * D + c) = pack8(a, b); }
                }
            }
    }
};

struct EpiQB {
    static constexpr bool PERM = false;
    bf16_t* QB; const float* SSQQ; const f32x2* cs;
    __device__ __forceinline__ void operator()(const Acc& acc, const Unit& u, int wr, int wc, int fr, int fq) const {
        const int pn = u.pn, row0 = u.pm * 256 + wr * 64 + fr;
#pragma unroll
        for (int ai = 0; ai < 2; ++ai)
#pragma unroll
            for (int m = 0; m < 4; ++m) {
                const int r = row0 + ai * 128 + m * 16;
                const f32x4 s0 = *(const f32x4*)(SSQQ + (size_t)r * 8), s1 = *(const f32x4*)(SSQQ + (size_t)r * 8 + 4);
                const float ss = ((s0[0] + s0[1]) + (s0[2] + s0[3])) + ((s1[0] + s1[1]) + (s1[2] + s1[3]));
                const float rinv = QB_SCALE / sqrtf(ss * (1.f / 384.f) + 1e-6f);
                if (pn < 2) {
#pragma unroll
                    for (int bj = 0; bj < 2; ++bj)
#pragma unroll
                        for (int n = 0; n < 2; ++n) { const int c = pn * 256 + bj * 128 + wc * 32 + n * 16 + 4 * fq; const f32x4 a = acc[ai][bj][m][n] * rinv;
                            u32x2 w; w.x = cvt_pk_bf16(a[0], a[1]); w.y = cvt_pk_bf16(a[2], a[3]);
                            *(u32x2*)(QB + (size_t)r * 768 + (c >> 6) * 96 + (c & 63)) = w; }
                } else {
#pragma unroll
                    for (int bj = 0; bj < 2; ++bj) { const int head = bj * 4 + wc; const f32x4 x1 = acc[ai][bj][m][0] * rinv, x2 = acc[ai][bj][m][1] * rinv; f32x4 o1, o2;
#pragma unroll
                        for (int j = 0; j < 4; ++j) { const f32x2 c_ = cs[(size_t)r * 16 + 4 * fq + j]; o1[j] = x1[j] * c_.x - x2[j] * c_.y; o2[j] = x2[j] * c_.x + x1[j] * c_.y; }
                        *(u32x4*)(QB + (size_t)r * 768 + head * 96 + 64 + 8 * fq) = pack8(o1, o2); }
                }
                asm volatile("" ::: "memory");
            }
    }
};

struct EpiKVB {
    static constexpr bool PERM = true;
    bf16_t *KB, *VB; const float* SSQKV;
    __device__ __forceinline__ void operator()(const Acc& acc, const Unit& u, int wr, int wc, int fr, int fq) const {
        const int pn = u.pn, row0 = u.pm * 256 + wr * 64 + fr;
#pragma unroll
        for (int ai = 0; ai < 2; ++ai)
#pragma unroll
            for (int m = 0; m < 4; ++m) {
                const int r = row0 + ai * 128 + m * 16;
                const f32x4 s0 = *(const f32x4*)(SSQKV + (size_t)r * 4);
                const float rinv = 1.f / sqrtf(((s0[0] + s0[1]) + (s0[2] + s0[3])) * (1.f / 256.f) + 1e-6f);
#pragma unroll
                for (int bj = 0; bj < 2; ++bj) { const int c = (pn & 1) * 256 + bj * 128 + wc * 32 + 8 * fq; const u32x4 w = pack8(acc[ai][bj][m][0] * rinv, acc[ai][bj][m][1] * rinv);
                    if (pn < 2) *(u32x4*)(KB + kimg_idx(r, c >> 6, (c & 63) >> 3)) = w; else *(u32x4*)(VB + vimg_idx(r, c >> 6, (c & 63) >> 3)) = w; }
            }
    }
};

template <int SECOND> struct EpiMG {
    static constexpr bool PERM = true;
    bf16_t* MG; const bf16_t* GT;
    __device__ __forceinline__ void operator()(const Acc& acc, const Unit& u, int wr, int wc, int fr, int fq) const {
        const int row0 = u.pm * 256 + wr * 64 + fr;
#pragma unroll
        for (int ai = 0; ai < 2; ++ai)
#pragma unroll
            for (int m = 0; m < 4; ++m) {
                const int r = row0 + ai * 128 + m * 16;
#pragma unroll
                for (int bj = 0; bj < 2; ++bj) { const size_t off = (size_t)r * D + u.pn * 256 + bj * 128 + wc * 32 + 8 * fq;
                    const u32x4 g = *(const u32x4*)(GT + off); f32x4 a = acc[ai][bj][m][0], b = acc[ai][bj][m][1];
                    a[0] *= bf_lo(g.x); a[1] *= bf_hi(g.x); a[2] *= bf_lo(g.y); a[3] *= bf_hi(g.y); b[0] *= bf_lo(g.z); b[1] *= bf_hi(g.z); b[2] *= bf_lo(g.w); b[3] *= bf_hi(g.w);
                    if (SECOND) { const u32x4 p = *(const u32x4*)(MG + off);
                        a[0] += bf_lo(p.x); a[1] += bf_hi(p.x); a[2] += bf_lo(p.y); a[3] += bf_hi(p.y); b[0] += bf_lo(p.z); b[1] += bf_hi(p.z); b[2] += bf_lo(p.w); b[3] += bf_hi(p.w); }
                    *(u32x4*)(MG + off) = pack8(a, b); }
            }
    }
};

struct EpiR1 {
    static constexpr bool PERM = false;
    float* R1; const float* x; const float* mod;
    __device__ __forceinline__ void operator()(const Acc& acc, const Unit& u, int wr, int wc, int fr, int fq) const {
        const int row0 = u.pm * 256 + wr * 64 + fr;
#pragma unroll
        for (int ai = 0; ai < 2; ++ai)
#pragma unroll
            for (int m = 0; m < 4; ++m) {
                const int r = row0 + ai * 128 + m * 16; const float* gp = mod + (r >> 11) * 6144 + 2048;
#pragma unroll
                for (int bj = 0; bj < 2; ++bj)
#pragma unroll
                    for (int n = 0; n < 2; ++n) { const int c = u.pn * 256 + bj * 128 + wc * 32 + n * 16 + 4 * fq;
                        const f32x4 xv = *(const f32x4*)(x + (size_t)r * D + c), g = *(const f32x4*)(gp + c);
                        *(f32x4*)(R1 + (size_t)r * D + c) = xv * ALPHA + g * acc[ai][bj][m][n]; }
            }
    }
};

struct EpiGU {
    static constexpr bool PERM = true;
    bf16_t* HE; const float* b_gate; const float* b_up;
    __device__ __forceinline__ void operator()(const Acc& acc, const Unit& u, int wr, int wc, int fr, int fq) const {
        const int e = u.x2, f0 = u.pn * 128 + wc * 32 + 8 * fq;
        const f32x4 bg0 = *(const f32x4*)(b_gate + e * D + f0), bg1 = *(const f32x4*)(b_gate + e * D + f0 + 4), bu0 = *(const f32x4*)(b_up + e * D + f0), bu1 = *(const f32x4*)(b_up + e * D + f0 + 4);
#pragma unroll
        for (int ai = 0; ai < 2; ++ai)
#pragma unroll
            for (int m = 0; m < 4; ++m) {
                const int rl = ai * 128 + wr * 64 + m * 16 + fr;
                f32x4 g0 = acc[ai][0][m][0] + bg0, g1 = acc[ai][0][m][1] + bg1, u0 = acc[ai][1][m][0] + bu0, u1 = acc[ai][1][m][1] + bu1;
#pragma unroll
                for (int j = 0; j < 4; ++j) {
                    const float ga = fminf(g0[j], 7.f), gb = fminf(g1[j], 7.f), ua = fminf(fmaxf(u0[j], -7.f), 7.f), ub = fminf(fmaxf(u1[j], -7.f), 7.f);
                    g0[j] = (ua + 1.f) * ga * fast_sigmoid(1.702f * ga); g1[j] = (ub + 1.f) * gb * fast_sigmoid(1.702f * gb); }
                if (rl < u.x1) *(u32x4*)(HE + (size_t)(u.x0 + rl) * D + f0) = pack8(g0, g1);
            }
    }
};

struct EpiDown {
    static constexpr bool PERM = true;
    bf16_t* YE; const float* b_down;
    __device__ __forceinline__ void operator()(const Acc& acc, const Unit& u, int wr, int wc, int fr, int fq) const {
        const int e = u.x2;
#pragma unroll
        for (int bj = 0; bj < 2; ++bj) { const int c = u.pn * 256 + bj * 128 + wc * 32 + 8 * fq;
            const f32x4 b0 = *(const f32x4*)(b_down + e * D + c), b1 = *(const f32x4*)(b_down + e * D + c + 4);
#pragma unroll
            for (int ai = 0; ai < 2; ++ai)
#pragma unroll
                for (int m = 0; m < 4; ++m) { const int rl = ai * 128 + wr * 64 + m * 16 + fr;
                    if (rl < u.x1) *(u32x4*)(YE + (size_t)(u.x0 + rl) * D + c) = pack8(acc[ai][bj][m][0] + b0, acc[ai][bj][m][1] + b1); } }
    }
};

struct GroupSched {
    const LAS int* utab; const LAS unsigned* gtab; const char* A; const char* B; size_t bstride; int K; int nloc; int gather;
    __device__ bool next(int i, Unit& u) const {
        if (i >= nloc) return false;
        const int e = __builtin_amdgcn_readfirstlane(utab[i * 8 + 0]), rb = __builtin_amdgcn_readfirstlane(utab[i * 8 + 1]), nv = __builtin_amdgcn_readfirstlane(utab[i * 8 + 2]), pn = __builtin_amdgcn_readfirstlane(utab[i * 8 + 3]);
        u.A = gather ? A : A + (size_t)rb * K * 2; u.B = B + (size_t)e * bstride + (size_t)pn * 256 * K * 2; u.pm = 0; u.pn = pn; u.x0 = rb; u.x1 = nv; u.x2 = e; u.slot = i; return true;
    }
    __device__ __forceinline__ unsigned goff(int slot, int r) const { return gtab[slot * 256 + r]; }
};
__device__ __forceinline__ int build_group_tables(Frame& F, int NPN, bool gather) {
    LAS int* cntL = (LAS int*)(F.lds + LX_CNT); LAS int* baseL = (LAS int*)(F.lds + LX_BASE); LAS int* bpre = (LAS int*)(F.lds + LX_BPRE); LAS int* nlocL = (LAS int*)(F.lds + LX_NLOC);
    LAS int* utab = (LAS int*)(F.lds + LX_UTAB); LAS unsigned* gtab = (LAS unsigned*)(F.lds + LX_GTAB);
    const int* cnt = (const int*)(F.ws + WS_CTL) + CW_CNT; const int* lists = (const int*)(F.ws + WS_LISTS);
    __syncthreads();
    if (F.tid < NE) cntL[F.tid] = cnt[F.tid];
    __syncthreads();
    if (F.tid == 0) { int s = 0, bs = 0; for (int e = 0; e < NE; ++e) { baseL[e] = s; bpre[e] = bs; s += cntL[e]; bs += (cntL[e] + 255) >> 8; } baseL[NE] = s; bpre[NE] = bs;
        const int total = bs * NPN; int nl = total > F.bx ? (total - F.bx + F.G - 1) / F.G : 0; if (nl > 10) nl = 10; nlocL[0] = nl; }
    __syncthreads();
    const int nloc = nlocL[0];
    if (F.tid < nloc) { const int ug = F.tid * F.G + F.bx, bi = ug / NPN, pn = ug - bi * NPN; int e = 0;
        for (int q = 1; q < NE; ++q) if (bpre[q] <= bi) e = q;
        const int jb = bi - bpre[e]; int nv = cntL[e] - 256 * jb; nv = nv > 256 ? 256 : nv;
        utab[F.tid * 8 + 0] = e; utab[F.tid * 8 + 1] = baseL[e] + 256 * jb; utab[F.tid * 8 + 2] = nv; utab[F.tid * 8 + 3] = pn; utab[F.tid * 8 + 4] = jb; }
    __syncthreads();
    if (gather) {
        for (int i = F.tid; i < nloc * 256; i += NTHR) { const int sl = i >> 8, r = i & 255; const int e = utab[sl * 8 + 0], nv = utab[sl * 8 + 2], jb = utab[sl * 8 + 4];
            const int tok = lists[e * T + 256 * jb + (r < nv ? r : 0)]; gtab[i] = (unsigned)tok * 2048u; }
        __syncthreads();
    }
    return nloc;
}
constexpr int ATT_KOFF = 0, ATT_PEOFF = 8192, ATT_VOFF = 12288, ATT_BUF = 20480, ATT_BIAS = 2 * ATT_BUF;
typedef short v4i16_t __attribute__((ext_vector_type(4)));
__device__ __forceinline__ s16x4 vtr(const LAS unsigned char* p) { return __builtin_bit_cast(s16x4, __builtin_amdgcn_ds_read_tr16_b64_v4i16((LAS v4i16_t*)p)); }

template <int KS, bool BAND>
__device__ __forceinline__ void attn_unit(Frame& F, int b, int h, int qb, const bf16_t* __restrict__ Q, int qpitch, int qhd, const bf16_t* __restrict__ Kimg, const bf16_t* __restrict__ PEimg, const bf16_t* __restrict__ Vimg,
                                          bf16_t* __restrict__ Y, const float* __restrict__ rel_bias) {
    const int tid = F.tid, lane = F.lane, w = F.wave, r32 = lane & 31, hi = lane >> 5;
    LAS unsigned char* lds = F.lds;
    const int c0 = 4 * qb, cw = c0 + (w >> 1);
    const int t_lo = BAND ? (c0 - 8 < 0 ? 0 : c0 - 8) : 0, t_hi = c0 + 3;
    const bf16_t* Kt = Kimg + (size_t)((b * 8 + h) * 32) * 4096; const bf16_t* Vt = Vimg + (size_t)((b * 8 + h) * 32) * 4096; const bf16_t* Pt = PEimg + (size_t)(b * 32) * 2048;
    __syncthreads();
    if (BAND) { LAS float* bl = (LAS float*)(lds + ATT_BIAS); for (int i = tid; i < 257; i += NTHR) bl[i] = rel_bias[h * 257 + i] * LOG2E; }
    const int qrow = b * S + qb * 256 + w * 32 + r32;
    bf16x8 qf[KS];
#pragma unroll
    for (int ks = 0; ks < KS; ++ks) qf[ks] = *(const bf16x8*)(Q + (size_t)qrow * qpitch + h * qhd + ks * 16 + hi * 8);
    u32x4 sk, sv, sp;
    { const int t = t_lo; sk = *(const u32x4*)(Kt + (size_t)t * 4096 + tid * 8); sv = *(const u32x4*)(Vt + (size_t)t * 4096 + tid * 8); if (KS == 6 && tid < 256) sp = *(const u32x4*)(Pt + (size_t)t * 2048 + tid * 8);
      *(LAS u32x4*)(lds + ATT_KOFF + tid * 16) = sk; *(LAS u32x4*)(lds + ATT_VOFF + tid * 16) = sv; if (KS == 6 && tid < 256) *(LAS u32x4*)(lds + ATT_PEOFF + tid * 16) = sp; }
    __syncthreads();
    f32x16 o0 = {}, o1 = {}; float mrow = -1e30f, lsum = 0.f;
    const int vb = ((lane >> 4) & 1) * 32 + (lane & 3) * 8 + (4 * hi + ((lane & 15) >> 2)) * 64;
    for (int t = t_lo; t <= t_hi; ++t) {
        const int cur = (t - t_lo) & 1; LAS unsigned char* buf = lds + cur * ATT_BUF; LAS unsigned char* nbuf = lds + (cur ^ 1) * ATT_BUF;
        const bool more = t < t_hi;
        if (more) { sk = *(const u32x4*)(Kt + (size_t)(t + 1) * 4096 + tid * 8); sv = *(const u32x4*)(Vt + (size_t)(t + 1) * 4096 + tid * 8); if (KS == 6 && tid < 256) sp = *(const u32x4*)(Pt + (size_t)(t + 1) * 2048 + tid * 8); }
        const bool active = BAND ? (t <= cw && t >= cw - 8) : (t <= cw);
        if (active) {
            f32x16 p0 = {}, p1 = {};
#pragma unroll
            for (int ks = 0; ks < KS; ++ks) {
                const LAS unsigned char* kb = (ks < 4) ? (buf + ATT_KOFF + (2 * ks + hi) * 1024 + r32 * 16) : (buf + ATT_PEOFF + (2 * (ks - 4) + hi) * 1024 + r32 * 16);
                const bf16x8 k0 = *(const LAS bf16x8*)kb, k1 = *(const LAS bf16x8*)(kb + 512);
                p0 = __builtin_amdgcn_mfma_f32_32x32x16_bf16(k0, qf[ks], p0, 0, 0, 0); p1 = __builtin_amdgcn_mfma_f32_32x32x16_bf16(k1, qf[ks], p1, 0, 0, 0);
            }
            if (BAND) {
                const LAS float* bl = (const LAS float*)(lds + ATT_BIAS); const int dl = cw - t;
                if (dl >= 3) { const float bc = bl[256];
#pragma unroll
                    for (int r = 0; r < 16; ++r) { p0[r] += bc; p1[r] += bc; } }
                else { const int base = 64 * dl + 32 * (w & 1) + r32 - 4 * hi + 128;
#pragma unroll
                    for (int r = 0; r < 16; ++r) { int i0 = base - ((r & 3) + 8 * (r >> 2)); int i1 = i0 - 32; i0 = i0 > 256 ? 256 : i0; i1 = i1 > 256 ? 256 : i1; p0[r] += bl[i0]; p1[r] += bl[i1]; } }
            }
            float mx = fmaxf(p0[0], p1[0]);
#pragma unroll
            for (int r = 1; r < 16; ++r) mx = fmaxf(mx, fmaxf(p0[r], p1[r]));
            mx = fmaxf(mx, __shfl_xor(mx, 32));
            const float mn = fmaxf(mrow, mx), al = __builtin_amdgcn_exp2f(mrow - mn); mrow = mn;
            float rs = 0.f;
#pragma unroll
            for (int r = 0; r < 16; ++r) { p0[r] = __builtin_amdgcn_exp2f(p0[r] - mn); p1[r] = __builtin_amdgcn_exp2f(p1[r] - mn); rs += p0[r] + p1[r]; }
            lsum = lsum * al + rs;
#pragma unroll
            for (int r = 0; r < 16; ++r) { o0[r] *= al; o1[r] *= al; }
            u32x4 pw[4];
            pw[0] = (u32x4){cvt_pk_bf16(p0[0], p0[1]), cvt_pk_bf16(p0[2], p0[3]), cvt_pk_bf16(p0[4], p0[5]), cvt_pk_bf16(p0[6], p0[7])};
            pw[1] = (u32x4){cvt_pk_bf16(p0[8], p0[9]), cvt_pk_bf16(p0[10], p0[11]), cvt_pk_bf16(p0[12], p0[13]), cvt_pk_bf16(p0[14], p0[15])};
            pw[2] = (u32x4){cvt_pk_bf16(p1[0], p1[1]), cvt_pk_bf16(p1[2], p1[3]), cvt_pk_bf16(p1[4], p1[5]), cvt_pk_bf16(p1[6], p1[7])};
            pw[3] = (u32x4){cvt_pk_bf16(p1[8], p1[9]), cvt_pk_bf16(p1[10], p1[11]), cvt_pk_bf16(p1[12], p1[13]), cvt_pk_bf16(p1[14], p1[15])};
            const LAS unsigned char* vbase = buf + ATT_VOFF + vb;
#pragma unroll
            for (int ks4 = 0; ks4 < 4; ++ks4) {
                const s16x4 a0 = vtr(vbase + ks4 * 1024), a1 = vtr(vbase + ks4 * 1024 + 512), c0_ = vtr(vbase + 4096 + ks4 * 1024), c1_ = vtr(vbase + 4096 + ks4 * 1024 + 512);
                const bf16x8 v0 = (bf16x8){a0[0], a0[1], a0[2], a0[3], a1[0], a1[1], a1[2], a1[3]}, v1 = (bf16x8){c0_[0], c0_[1], c0_[2], c0_[3], c1_[0], c1_[1], c1_[2], c1_[3]};
                const bf16x8 pf = __builtin_bit_cast(bf16x8, pw[ks4]);
                o0 = __builtin_amdgcn_mfma_f32_32x32x16_bf16(v0, pf, o0, 0, 0, 0); o1 = __builtin_amdgcn_mfma_f32_32x32x16_bf16(v1, pf, o1, 0, 0, 0);
            }
        }
        if (more) { *(LAS u32x4*)(nbuf + ATT_KOFF + tid * 16) = sk; *(LAS u32x4*)(nbuf + ATT_VOFF + tid * 16) = sv; if (KS == 6 && tid < 256) *(LAS u32x4*)(nbuf + ATT_PEOFF + tid * 16) = sp; }
        __syncthreads();
    }
    lsum += __shfl_xor(lsum, 32);
    const float il = 1.f / lsum;
    bf16_t* yo = Y + (size_t)qrow * 512 + h * 64;
#pragma unroll
    for (int g = 0; g < 4; ++g) {
        u32x2 w0, w1; w0.x = cvt_pk_bf16(o0[4 * g] * il, o0[4 * g + 1] * il); w0.y = cvt_pk_bf16(o0[4 * g + 2] * il, o0[4 * g + 3] * il);
        w1.x = cvt_pk_bf16(o1[4 * g] * il, o1[4 * g + 1] * il); w1.y = cvt_pk_bf16(o1[4 * g + 2] * il, o1[4 * g + 3] * il);
        *(u32x2*)(yo + 8 * g + 4 * hi) = w0; *(u32x2*)(yo + 32 + 8 * g + 4 * hi) = w1;
    }
}

__device__ __forceinline__ void p4_attention(Frame& F) {
    const int vcu = (F.G % 8 == 0) ? (F.bx % 8) * (F.G / 8) + F.bx / 8 : F.bx;
    const bf16_t* QA = (const bf16_t*)(F.ws + WS_QA); const bf16_t* KA = (const bf16_t*)(F.ws + WS_KA); const bf16_t* VA = (const bf16_t*)(F.ws + WS_VA);
    const bf16_t* QB = (const bf16_t*)(F.ws + WS_QB); const bf16_t* KB = (const bf16_t*)(F.ws + WS_KB); const bf16_t* VB = (const bf16_t*)(F.ws + WS_VB); const bf16_t* KPE = (const bf16_t*)(F.ws + WS_KPE);
    bf16_t* YA = (bf16_t*)(F.ws + WS_YA); bf16_t* YB = (bf16_t*)(F.ws + WS_YB);
    for (int v = vcu; v < 256; v += F.G) {
        const int bh = v >> 2, s = v & 3, b = bh >> 3, h = bh & 7;
        attn_unit<6, false>(F, b, h, s, QB, 768, 96, KB, KPE, VB, YB, nullptr);
        attn_unit<6, false>(F, b, h, 7 - s, QB, 768, 96, KB, KPE, VB, YB, nullptr);
        attn_unit<4, true>(F, b, h, s, QA, 512, 64, KA, KPE, VA, YA, F.rel_bias);
        attn_unit<4, true>(F, b, h, 7 - s, QA, 512, 64, KA, KPE, VA, YA, F.rel_bias);
    }
    __syncthreads();
}

constexpr int P7_TE = LX_GTAB, P7_TW = LX_GTAB + 1024, P7_LR = LX_GTAB + 2048, P7_LCNT = LX_GTAB + 3072, P7_GBASE = LX_GTAB + 3328;
__device__ __forceinline__ void p7_ln_router(Frame& F) {
    LAS float* WT = (LAS float*)F.lds;
    LAS int* teL = (LAS int*)(F.lds + P7_TE); LAS float* twL = (LAS float*)(F.lds + P7_TW); LAS int* lrL = (LAS int*)(F.lds + P7_LR); LAS int* lcnt = (LAS int*)(F.lds + P7_LCNT); LAS int* gbase = (LAS int*)(F.lds + P7_GBASE);
    const float* mod = (const float*)(F.ws + WS_MOD); bf16_t* H2 = (bf16_t*)(F.ws + WS_H2);
    int* cnt = (int*)(F.ws + WS_CTL) + CW_CNT; int* lists = (int*)(F.ws + WS_LISTS); int* TE = (int*)(F.ws + WS_TE); float* TW = (float*)(F.ws + WS_TW); int* TP = (int*)(F.ws + WS_TP);
    __syncthreads();
    for (int i = F.tid; i < 1024 * 8; i += NTHR) { const int k = i >> 3, e4 = (i & 7) * 4; const f32x4 v = *(const f32x4*)(F.w_router + (size_t)k * 32 + e4);
        WT[(e4 + 0) * 1024 + k] = v.x; WT[(e4 + 1) * 1024 + k] = v.y; WT[(e4 + 2) * 1024 + k] = v.z; WT[(e4 + 3) * 1024 + k] = v.w; }
    for (int blk = F.bx; blk < T / 64; blk += F.G) {
        const int b = (blk * 64) / S; const float* sh2 = mod + b * 6144 + 3072; const float* sc2 = mod + b * 6144 + 4096;
        __syncthreads();
        if (F.tid < NE) lcnt[F.tid] = 0;
        __syncthreads();
        for (int rr = F.wave; rr < 64; rr += NWAVES) {
            const int row = blk * 64 + rr, lane = F.lane;
            f32x4* xr = (f32x4*)(F.out + (size_t)row * D) + lane;
            f32x4 v[4]; float s = 0.f;
#pragma unroll
            for (int j = 0; j < 4; ++j) { v[j] = xr[64 * j]; s += (v[j].x + v[j].y) + (v[j].z + v[j].w); }
            const float mean = wave_sum(s) * (1.f / D); float s2 = 0.f;
#pragma unroll
            for (int j = 0; j < 4; ++j) { v[j] = v[j] - mean; s2 += (v[j].x * v[j].x + v[j].y * v[j].y) + (v[j].z * v[j].z + v[j].w * v[j].w); }
            const float rstd = 1.f / sqrtf(wave_sum(s2) * (1.f / D) + 1e-5f);
            u32x2* ho = (u32x2*)(H2 + (size_t)row * D) + lane;
#pragma unroll
            for (int j = 0; j < 4; ++j) { const int k = 4 * lane + 256 * j; const f32x4 gg = *(const f32x4*)(F.ln1_g + k), bb = *(const f32x4*)(F.ln1_b + k);
                v[j] = v[j] * rstd * gg + bb; xr[64 * j] = v[j];
                const f32x4 c2 = *(const f32x4*)(sc2 + k), s2v = *(const f32x4*)(sh2 + k);
                v[j] = v[j] * (c2 + 1.f) + s2v;
                u32x2 wv; wv.x = cvt_pk_bf16(v[j].x, v[j].y); wv.y = cvt_pk_bf16(v[j].z, v[j].w); ho[64 * j] = wv; }
            float a[32];
#pragma unroll
            for (int e = 0; e < 32; ++e) { float t_ = 0.f;
#pragma unroll
                for (int j = 0; j < 4; ++j) { const f32x4 wv = *(const LAS f32x4*)(WT + e * 1024 + 4 * lane + 256 * j); t_ += (v[j].x * wv.x + v[j].y * wv.y) + (v[j].z * wv.z + v[j].w * wv.w); }
                a[e] = t_; }
            float c16[16];
#pragma unroll
            for (int i = 0; i < 16; ++i) { const bool up = (lane & 32) != 0; const float keep = up ? a[16 + i] : a[i], send = up ? a[i] : a[16 + i]; c16[i] = keep + __shfl_xor(send, 32); }
            float c8[8];
#pragma unroll
            for (int i = 0; i < 8; ++i) { const bool up = (lane & 16) != 0; const float keep = up ? c16[8 + i] : c16[i], send = up ? c16[i] : c16[8 + i]; c8[i] = keep + __shfl_xor(send, 16); }
            float c4[4];
#pragma unroll
            for (int i = 0; i < 4; ++i) { const bool up = (lane & 8) != 0; const float keep = up ? c8[4 + i] : c8[i], send = up ? c8[i] : c8[4 + i]; c4[i] = keep + __shfl_xor(send, 8); }
            float c2_[2];
#pragma unroll
            for (int i = 0; i < 2; ++i) { const bool up = (lane & 4) != 0; const float keep = up ? c4[2 + i] : c4[i], send = up ? c4[i] : c4[2 + i]; c2_[i] = keep + __shfl_xor(send, 4); }
            float c1; { const bool up = (lane & 2) != 0; const float keep = up ? c2_[1] : c2_[0], send = up ? c2_[0] : c2_[1]; c1 = keep + __shfl_xor(send, 2); }
            c1 += __shfl_xor(c1, 1);
            const int e = ((lane >> 5) << 4) | (((lane >> 4) & 1) << 3) | (((lane >> 3) & 1) << 2) | (((lane >> 2) & 1) << 1) | ((lane >> 1) & 1);
            float lv = c1 + F.b_router[e];
            float tv[4]; int ti[4];
#pragma unroll
            for (int r = 0; r < 4; ++r) { float bv = lv; int bi = e;
#pragma unroll
                for (int o = 1; o < 64; o <<= 1) { const float ov = __shfl_xor(bv, o); const int oi = __shfl_xor(bi, o); if (ov > bv || (ov == bv && oi < bi)) { bv = ov; bi = oi; } }
                tv[r] = bv; ti[r] = bi; if (e == bi) lv = -3.0e38f; }
            const float e1 = __expf(tv[1] - tv[0]), e2 = __expf(tv[2] - tv[0]), e3 = __expf(tv[3] - tv[0]); const float is = 1.f / (1.f + e1 + e2 + e3);
            if (lane < 4) { const int ee = lane == 0 ? ti[0] : lane == 1 ? ti[1] : lane == 2 ? ti[2] : ti[3]; const float ww = (lane == 0 ? 1.f : lane == 1 ? e1 : lane == 2 ? e2 : e3) * is;
                teL[rr * 4 + lane] = ee; twL[rr * 4 + lane] = ww; lrL[rr * 4 + lane] = __hip_atomic_fetch_add(&lcnt[ee], 1, __ATOMIC_RELAXED, __HIP_MEMORY_SCOPE_WORKGROUP); }
        }
        __syncthreads();
        if (F.tid < NE) { const int n = lcnt[F.tid]; gbase[F.tid] = n ? atomicAdd(&cnt[F.tid], n) : 0; }
        __syncthreads();
        if (F.tid < 256) { const int rr = F.tid >> 2, k = F.tid & 3, t = blk * 64 + rr; const int ee = teL[F.tid], p = gbase[ee] + lrL[F.tid];
            lists[ee * T + p] = t; TE[t * 4 + k] = ee; TW[t * 4 + k] = twL[F.tid]; TP[t * 4 + k] = p; }
    }
    __syncthreads();
}

__device__ __forceinline__ void p10_final(Frame& F) {
    const float* mod = (const float*)(F.ws + WS_MOD); const bf16_t* YE = (const bf16_t*)(F.ws + WS_YE);
    const int* TE = (const int*)(F.ws + WS_TE); const float* TW = (const float*)(F.ws + WS_TW); const int* TP = (const int*)(F.ws + WS_TP);
    LAS int* cntL = (LAS int*)(F.lds + LX_CNT); LAS int* baseL = (LAS int*)(F.lds + LX_BASE);
    const int* cnt = (const int*)(F.ws + WS_CTL) + CW_CNT;
    __syncthreads();
    if (F.tid < NE) cntL[F.tid] = cnt[F.tid];
    __syncthreads();
    if (F.tid == 0) { int s = 0; for (int e = 0; e < NE; ++e) { baseL[e] = s; s += cntL[e]; } }
    __syncthreads();
    for (int blk = F.bx; blk < T / 64; blk += F.G) {
        const int b = (blk * 64) / S; const float* g2 = mod + b * 6144 + 5120;
        for (int rr = F.wave; rr < 64; rr += NWAVES) {
            const int row = blk * 64 + rr, lane = F.lane;
            f32x4* xr = (f32x4*)(F.out + (size_t)row * D) + lane;
            f32x4 f[4];
#pragma unroll
            for (int j = 0; j < 4; ++j) f[j] = (f32x4){0.f, 0.f, 0.f, 0.f};
#pragma unroll
            for (int k = 0; k < 4; ++k) { const int e = TE[row * 4 + k]; const float w = TW[row * 4 + k]; const size_t yr = (size_t)(baseL[e] + TP[row * 4 + k]);
                const u32x2* yp = (const u32x2*)(YE + yr * D) + lane;
#pragma unroll
                for (int j = 0; j < 4; ++j) { const u32x2 y = yp[64 * j]; f[j].x += w * bf_lo(y.x); f[j].y += w * bf_hi(y.x); f[j].z += w * bf_lo(y.y); f[j].w += w * bf_hi(y.y); } }
            f32x4 v[4]; float s = 0.f;
#pragma unroll
            for (int j = 0; j < 4; ++j) { const f32x4 gg = *(const f32x4*)(g2 + 4 * lane + 256 * j); v[j] = xr[64 * j] * ALPHA + gg * f[j]; s += (v[j].x + v[j].y) + (v[j].z + v[j].w); }
            const float mean = wave_sum(s) * (1.f / D); float s2 = 0.f;
#pragma unroll
            for (int j = 0; j < 4; ++j) { v[j] = v[j] - mean; s2 += (v[j].x * v[j].x + v[j].y * v[j].y) + (v[j].z * v[j].z + v[j].w * v[j].w); }
            const float rstd = 1.f / sqrtf(wave_sum(s2) * (1.f / D) + 1e-5f);
#pragma unroll
            for (int j = 0; j < 4; ++j) { const int k = 4 * lane + 256 * j; const f32x4 gg = *(const f32x4*)(F.ln2_g + k), bb = *(const f32x4*)(F.ln2_b + k); xr[64 * j] = v[j] * rstd * gg + bb; }
        }
    }
}
constexpr int N_PHASES = 11;
__global__ void __launch_bounds__(NTHR, 2) mega_fwd(KP kp) {
    extern __shared__ __attribute__((aligned(16))) unsigned char lds_raw[];
    Frame F;
    F.lds = (LAS unsigned char*)lds_raw; F.tid = threadIdx.x; F.lane = F.tid & 63; F.wave = __builtin_amdgcn_readfirstlane(F.tid >> 6); F.G = gridDim.x; F.bx = blockIdx.x;
    F.x = kp.in[0]; F.c = kp.in[1]; F.pos = (const int*)kp.in[2]; F.w_ada = kp.in[3]; F.b_ada = kp.in[4]; F.w_in = kp.in[5]; F.rms_q = kp.in[6]; F.w_uq = kp.in[7]; F.rms_kv = kp.in[8]; F.w_ukv = kp.in[9];
    F.rel_bias = kp.in[10]; F.wba = kp.in[11]; F.wbb = kp.in[12]; F.w_out = kp.in[13]; F.ln1_g = kp.in[14]; F.ln1_b = kp.in[15]; F.w_router = kp.in[16]; F.b_router = kp.in[17];
    F.w_gate = kp.in[18]; F.b_gate = kp.in[19]; F.w_up = kp.in[20]; F.b_up = kp.in[21]; F.w_down = kp.in[22]; F.b_down = kp.in[23]; F.ln2_g = kp.in[24]; F.ln2_b = kp.in[25];
    F.out = kp.out; F.ws = kp.ws;
    for (int u = F.tid; u < (LDS_BYTES - LDSX) / 4; u += NTHR) ((LAS unsigned*)(F.lds + LDSX))[u] = 0u;
    __syncthreads();
    const int lo = kp.ph_lo, hi = kp.ph_hi;
    const bool multi = (hi - lo) > 1;
    XcdBarrier bar; bar.bar = (unsigned*)(F.ws + WS_CTL) + CW_BAR; bar.x = 0; bar.st = nullptr;
    if (multi) bar = xcd_barrier_post((unsigned*)(F.ws + WS_CTL) + CW_BAR, (volatile LAS unsigned*)(F.lds + LX_MISC) + 8);
#ifndef FK_PHASE_MASK
#define FK_PHASE_MASK 0x7ff
#endif
#define IN(k) (((FK_PHASE_MASK >> (k)) & 1) && lo <= (k) && (k) < hi)
#define SEAM(k) do { if (IN(k) && IN((k) + 1)) xcd_barrier(bar); } while (0)
    unsigned char* ws = F.ws;
    LAS unsigned char* ring = F.lds;

    if (IN(0)) { p0_prologue(F); } SEAM(0);
    if (IN(1)) { p1_h1(F); } SEAM(1);
    if (IN(2)) {
        pg8::StaticOrder S; S.init(ws + WS_H1, ws + WS_WIN, T, NPAD_WIN, D, F.G, F.bx);
        EpiZ E{(bf16_t*)(ws + WS_QA), (bf16_t*)(ws + WS_KA), (bf16_t*)(ws + WS_VA), (bf16_t*)(ws + WS_CQ), (bf16_t*)(ws + WS_CKV), (bf16_t*)(ws + WS_KPE), (bf16_t*)(ws + WS_GA), (bf16_t*)(ws + WS_GB),
               (float*)(ws + WS_SSQQ), (float*)(ws + WS_SSQKV), (const f32x2*)(ws + WS_CS)};
        pg8::gemm_phase<EpiZ, pg8::StaticOrder, true, false>(ring, D, S, E);
    } SEAM(2);
    if (IN(3)) {
        { pg8::StaticOrder S; S.init(ws + WS_CQ, ws + WS_WUQ, T, 768, 384, F.G, F.bx);
          EpiQB E{(bf16_t*)(ws + WS_QB), (const float*)(ws + WS_SSQQ), (const f32x2*)(ws + WS_CS)};
          pg8::gemm_phase<EpiQB, pg8::StaticOrder, true, false>(ring, 384, S, E); }
        { pg8::StaticOrder S; S.init(ws + WS_CKV, ws + WS_WUKV, T, 1024, 256, F.G, F.bx);
          EpiKVB E{(bf16_t*)(ws + WS_KB), (bf16_t*)(ws + WS_VB), (const float*)(ws + WS_SSQKV)};
          pg8::gemm_phase<EpiKVB, pg8::StaticOrder, true, false>(ring, 256, S, E); }
    } SEAM(3);
    if (IN(4)) { p4_attention(F); } SEAM(4);
    if (IN(5)) {
        { pg8::StaticOrder S; S.init(ws + WS_YA, ws + WS_WBA, T, D, 512, F.G, F.bx);
          EpiMG<0> E{(bf16_t*)(ws + WS_MG), (const bf16_t*)(ws + WS_GA)};
          pg8::gemm_phase<EpiMG<0>, pg8::StaticOrder, true, false>(ring, 512, S, E); }
        VM_WAIT(); __syncthreads();
        { pg8::StaticOrder S; S.init(ws + WS_YB, ws + WS_WBB, T, D, 512, F.G, F.bx);
          EpiMG<1> E{(bf16_t*)(ws + WS_MG), (const bf16_t*)(ws + WS_GB)};
          pg8::gemm_phase<EpiMG<1>, pg8::StaticOrder, true, false>(ring, 512, S, E); }
    } SEAM(5);
    if (IN(6)) {
        pg8::StaticOrder S; S.init(ws + WS_MG, ws + WS_WOUT, T, D, D, F.G, F.bx);
        EpiR1 E{F.out, F.x, (const float*)(ws + WS_MOD)};
        pg8::gemm_phase<EpiR1, pg8::StaticOrder, true, false>(ring, D, S, E);
    } SEAM(6);
    if (IN(7)) { p7_ln_router(F); } SEAM(7);
    if (IN(8)) {
        const int nloc = build_group_tables(F, 8, true);
        GroupSched S{(const LAS int*)(F.lds + LX_UTAB), (const LAS unsigned*)(F.lds + LX_GTAB), (const char*)(ws + WS_H2), (const char*)(ws + WS_WGU), (size_t)2048 * D * 2, D, nloc, 1};
        EpiGU E{(bf16_t*)(ws + WS_HE), F.b_gate, F.b_up};
        pg8::gemm_phase<EpiGU, GroupSched, true, true>(ring, D, S, E);
    } SEAM(8);
    if (IN(9)) {
        const int nloc = build_group_tables(F, 4, false);
        GroupSched S{(const LAS int*)(F.lds + LX_UTAB), (const LAS unsigned*)(F.lds + LX_GTAB), (const char*)(ws + WS_HE), (const char*)(ws + WS_WD), (size_t)D * D * 2, D, nloc, 0};
        EpiDown E{(bf16_t*)(ws + WS_YE), F.b_down};
        pg8::gemm_phase<EpiDown, GroupSched, true, false>(ring, D, S, E);
    } SEAM(9);
    if (IN(10)) { p10_final(F); }
#undef IN
#undef SEAM
}

static int g_grid = 0;
static bool fast_setup() {
    if (g_grid) return g_grid > 0;
    int dev = 0, cus = 0;
    if (hipGetDevice(&dev) != hipSuccess || hipDeviceGetAttribute(&cus, hipDeviceAttributeMultiprocessorCount, dev) != hipSuccess) { g_grid = -1; return false; }
    if (hipFuncSetAttribute((const void*)mega_fwd, hipFuncAttributeMaxDynamicSharedMemorySize, LDS_BYTES) != hipSuccess) { fprintf(stderr, "hipFuncSetAttribute failed\n"); g_grid = -1; return false; }
    int per_cu = 0;
    if (hipOccupancyMaxActiveBlocksPerMultiprocessor(&per_cu, (const void*)mega_fwd, NTHR, LDS_BYTES) != hipSuccess || per_cu < 1) fprintf(stderr, "occupancy query says %d\n", per_cu);
    (void)hipGetLastError();
    g_grid = cus;
    return true;
}
static void launch_phases(void* const* d_in, float* out, void* d_ws, hipStream_t st, int lo, int hi) {
    KP kp{};
    for (int i = 0; i < 26; ++i) kp.in[i] = (const float*)d_in[i];
    kp.out = out; kp.ws = (unsigned char*)d_ws; kp.ph_lo = lo; kp.ph_hi = hi;
    hipLaunchKernelGGL(mega_fwd, dim3(g_grid), dim3(NTHR), LDS_BYTES, st, kp);
}
}
#ifndef FK_LAUNCHES
#define FK_LAUNCHES 1
#endif
extern "C" void kernel_launch(void* const* d_in, const int* in_sizes, int n_in, void* d_out, int out_size, void* d_ws, size_t ws_size, hipStream_t stream) {
    (void)in_sizes; (void)n_in; (void)out_size;
    if (!fk::fast_setup()) return;
    if (ws_size < fk::WS_END) { fprintf(stderr, "workspace too small: %zu\n", ws_size); return; }
    (void)hipMemsetAsync(d_ws, 0, fk::CTL_ZERO_BYTES, stream);
    if (FK_LAUNCHES == 1) fk::launch_phases(d_in, (float*)d_out, d_ws, stream, 0, fk::N_PHASES);
    else for (int p = 0; p < fk::N_PHASES; ++p) fk::launch_phases(d_in, (float*)d_out, d_ws, stream, p, p + 1);
}
```

```cpp
#include <hip/hip_runtime.h>
#include <cstdio>
#include <cstdint>
namespace pg8 {
#define PG8_LAS __attribute__((address_space(3)))
typedef unsigned short bf16_t;
typedef short bf16x8 __attribute__((ext_vector_type(8)));
typedef float f32x4 __attribute__((ext_vector_type(4)));
typedef unsigned u32x4 __attribute__((ext_vector_type(4)));
typedef unsigned u32x2 __attribute__((ext_vector_type(2)));
typedef int i32x4 __attribute__((ext_vector_type(4)));
typedef int i32x8 __attribute__((ext_vector_type(8)));
constexpr int BM = 256, BK = 64, HALF = 128, HTB = HALF * BK * 2, STAGE_BYTES = 8 * HTB, NXCD = 8, WGM = 8;

__host__ __device__ __forceinline__ int lds_byte(int r, int c) { const int st = (r >> 4) * 2 + (c >> 5), rr = r & 15, cc = c & 31, ob = rr * 64 + cc * 2; return st * 1024 + (ob ^ (((ob >> 9) & 1) << 5)); }
__host__ __device__ __forceinline__ void stage_rc(int b, int& R, int& C) { const int st = b / 1024, sb = b % 1024, swz = sb ^ (((sb >> 9) & 1) << 5); R = (st >> 1) * 16 + swz / 64; C = (st & 1) * 32 + (swz % 64) / 2; }
__host__ __device__ __forceinline__ int perm32(int rho) { const int n = rho >> 4, i = rho & 15; return 8 * (i >> 2) + 4 * n + (i & 3); }

struct Unit { const char* A; const char* B; int pm, pn, x0, x1, x2, slot; };

struct StaticOrder {
    const char* A; const char* B; int K; int nM, nN, nwg, G, c;
    __device__ void init(const void* A_, const void* B_, int M, int N, int K_, int G_, int c_) { A = (const char*)A_; B = (const char*)B_; K = K_; nM = M / BM; nN = N / BM; nwg = nM * nN; G = G_; c = c_; }
    __device__ bool next(int i, Unit& u) const {
        const long L = (long)i * G + c; if (L >= nwg) return false;
        int wgid = (int)L; { const int q = nwg / NXCD, r = nwg % NXCD, xcd = wgid % NXCD, off = wgid / NXCD; wgid = (xcd < r ? xcd * (q + 1) : r * (q + 1) + (xcd - r) * q) + off; }
        const int nig = WGM * nN, gid = wgid / nig, fm = gid * WGM, gsz = (nM - fm) < WGM ? (nM - fm) : WGM;
        u.pm = fm + ((wgid % nig) % gsz); u.pn = (wgid % nig) / gsz;
        u.A = A + (size_t)u.pm * BM * K * 2; u.B = B + (size_t)u.pn * BM * K * 2; u.x0 = 0; u.x1 = 0; u.x2 = 0; u.slot = 0; return true;
    }
    __device__ __forceinline__ unsigned goff(int, int) const { return 0u; }
};

__device__ __forceinline__ unsigned cvt_pk_bf16(float lo, float hi) { unsigned r; asm volatile("v_cvt_pk_bf16_f32 %0, %1, %2" : "=v"(r) : "v"(lo), "v"(hi)); return r; }
__device__ __forceinline__ float bf_lo(unsigned w) { return __uint_as_float(w << 16); }
__device__ __forceinline__ float bf_hi(unsigned w) { return __uint_as_float(w & 0xffff0000u); }

__device__ __forceinline__ void glds16_s(const char* sbase, unsigned voff, unsigned ldsaddr) {
    asm volatile("s_mov_b32 m0, %2\n\ts_nop 0\n\tglobal_load_lds_dwordx4 %0, %1" :: "v"(voff), "s"(sbase), "s"(ldsaddr) : "memory", "m0");
}
template <class Epi, class Sched, bool ALIGN_EPI, bool GATHER, bool FP8 = false>
__device__ __forceinline__ void gemm_phase(PG8_LAS unsigned char* lds, const int K, const Sched& S, const Epi& E) {
    int tid_o = threadIdx.x; asm volatile("" : "+v"(tid_o));
    const int tid = tid_o, wid = __builtin_amdgcn_readfirstlane(tid >> 6), lane = tid & 63, wr = wid >> 2, wc = wid & 3, fr = lane & 15, fq = lane >> 4;
    const int nt = K / BK;
    unsigned voffA[2], voffB[2]; int RA[2]; unsigned CA2[2];
#pragma unroll
    for (int i = 0; i < 2; ++i) { int R, C; stage_rc(tid * 16 + i * 8192, R, C); const int Rb = Epi::PERM ? ((R & ~31) + perm32(R & 31)) : R;
        voffA[i] = (unsigned)(R * K + C) * 2u; voffB[i] = (unsigned)(Rb * K + C) * 2u; RA[i] = R; CA2[i] = (unsigned)C * 2u; }
    const size_t kstep = (size_t)(BK * 2);
    const size_t hstep = (size_t)HALF * K * 2;
    const unsigned ldsw = (unsigned)wid * 1024u;
    const unsigned lds32 = (unsigned)(size_t)lds;
    const int aoff = lds_byte(wr * 64 + fr, fq * 8), boff = lds_byte(wc * 32 + fr, fq * 8);
#define PG8_SA(b, h) (((b) * 2 + (h)) * HTB)
#define PG8_SB(b, h) ((4 + (b) * 2 + (h)) * HTB)
#define PG8_STAGE(bufoff, gbase, voff) do { _Pragma("unroll") for (int _i = 0; _i < 2; ++_i) \
        glds16_s((const char*)(gbase), (voff)[_i], lds32 + (unsigned)(bufoff) + ldsw + (unsigned)(_i * 8192)); } while (0)
#define PG8_STAGE_A(bufoff, gbase, h, nx) do { if constexpr (GATHER) { PG8_STAGE(bufoff, gbase, gA[h]); } else { PG8_STAGE(bufoff, (gbase) + (h) * hstep, voffA); } } while (0)
#define PG8_LD8(p) __builtin_shufflevector(*(const PG8_LAS i32x4*)(p), *(const PG8_LAS i32x4*)((p) + 1024), 0, 1, 2, 3, 4, 5, 6, 7)
#define PG8_LDA(dst, b, h) do { _Pragma("unroll") for (int m = 0; m < 4; ++m) dst[m] = PG8_LD8(lds + PG8_SA(b, h) + aoff + m * 2048); } while (0)
#define PG8_LDB(dst, b, h) do { _Pragma("unroll") for (int n = 0; n < 2; ++n) dst[n] = PG8_LD8(lds + PG8_SB(b, h) + boff + n * 2048); } while (0)
#define PG8_LO(v) __builtin_bit_cast(bf16x8, __builtin_shufflevector(v, v, 0, 1, 2, 3))
#define PG8_HI(v) __builtin_bit_cast(bf16x8, __builtin_shufflevector(v, v, 4, 5, 6, 7))
#define PG8_MMA(ai, bj, At, Bt) do { __builtin_amdgcn_s_setprio(1); \
        if constexpr (FP8) { _Pragma("unroll") for (int m = 0; m < 4; ++m) _Pragma("unroll") for (int n = 0; n < 2; ++n) \
            acc[ai][bj][m][n] = __builtin_amdgcn_mfma_scale_f32_16x16x128_f8f6f4(Bt[n], At[m], acc[ai][bj][m][n], 0, 0, 0, 0x7f7f7f7f, 0, 0x7f7f7f7f); } \
        else { _Pragma("unroll") for (int m = 0; m < 4; ++m) _Pragma("unroll") for (int n = 0; n < 2; ++n) { \
            acc[ai][bj][m][n] = __builtin_amdgcn_mfma_f32_16x16x32_bf16(PG8_LO(Bt[n]), PG8_LO(At[m]), acc[ai][bj][m][n], 0, 0, 0); \
            acc[ai][bj][m][n] = __builtin_amdgcn_mfma_f32_16x16x32_bf16(PG8_HI(Bt[n]), PG8_HI(At[m]), acc[ai][bj][m][n], 0, 0, 0); } } \
        __builtin_amdgcn_s_setprio(0); } while (0)
#define PG8_WAIT_V(n) asm volatile("s_waitcnt vmcnt(" #n ")" ::: "memory")
#define PG8_WAIT_L(n) asm volatile("s_waitcnt lgkmcnt(" #n ")" ::: "memory")
#define PG8_BAR __builtin_amdgcn_s_barrier()
#define PG8_SCHED __builtin_amdgcn_sched_barrier(0)
    Unit cur, nxt; int ui = 0;
    if (!S.next(0, cur)) return;
    unsigned gA[2][2];
    if constexpr (GATHER) {
#pragma unroll
        for (int h = 0; h < 2; ++h)
#pragma unroll
            for (int i = 0; i < 2; ++i) gA[h][i] = S.goff(cur.slot, h * HALF + RA[i]) + CA2[i];
    }
    f32x4 acc[2][2][4][2];
#pragma unroll
    for (int a = 0; a < 2; ++a)
#pragma unroll
        for (int b = 0; b < 2; ++b)
#pragma unroll
            for (int m = 0; m < 4; ++m)
#pragma unroll
                for (int n = 0; n < 2; ++n) acc[a][b][m][n] = (f32x4){0.f, 0.f, 0.f, 0.f};
    i32x8 At[4], B0[2], B1[2];
    const char* cA = cur.A; const char* cB = cur.B;
    PG8_STAGE(PG8_SB(0, 0), cB, voffB); PG8_STAGE(PG8_SB(0, 1), cB + hstep, voffB); PG8_STAGE_A(PG8_SA(0, 0), cA, 0, false); PG8_STAGE_A(PG8_SA(0, 1), cA, 1, false);
    if (wr == 1) PG8_BAR;
    PG8_WAIT_V(2); PG8_BAR;
    PG8_STAGE(PG8_SB(1, 0), cB + kstep, voffB); PG8_STAGE_A(PG8_SA(1, 0), cA + kstep, 0, false); PG8_STAGE(PG8_SB(1, 1), cB + hstep + kstep, voffB);
    PG8_WAIT_V(6); PG8_BAR;
    for (;;) {
        const bool has_next = S.next(ui + 1, nxt);
        const char* nA = has_next ? nxt.A : cA; const char* nB = has_next ? nxt.B : cB;
#pragma unroll 1
        for (int t = 0; t < nt; t += 2) {
            const bool last = (t == nt - 2);
            const char* a1 = cA + (size_t)(t + 1) * kstep;
            const char* a2 = last ? nA : cA + (size_t)(t + 2) * kstep; const char* b2 = last ? nB : cB + (size_t)(t + 2) * kstep;
            const char* a3 = a2 + kstep; const char* b3 = b2 + kstep;
            PG8_LDB(B0, 0, 0); PG8_LDB(B1, 0, 1); PG8_SCHED; PG8_LDA(At, 0, 0); PG8_STAGE_A(PG8_SA(1, 1), a1, 1, false);
            if constexpr (GATHER) { if (last && has_next) {
#pragma unroll
                for (int h = 0; h < 2; ++h)
#pragma unroll
                    for (int i = 0; i < 2; ++i) gA[h][i] = S.goff(nxt.slot, h * HALF + RA[i]) + CA2[i]; } }
            PG8_WAIT_V(8); PG8_WAIT_L(0); PG8_BAR; PG8_MMA(0, 0, At, B0); PG8_MMA(0, 1, At, B1); PG8_BAR; PG8_SCHED;
            PG8_LDA(At, 0, 1); PG8_STAGE(PG8_SB(0, 0), b2, voffB); PG8_STAGE(PG8_SB(0, 1), b2 + hstep, voffB); PG8_STAGE_A(PG8_SA(0, 0), a2, 0, last);
            PG8_WAIT_V(8); PG8_WAIT_L(0); PG8_BAR; PG8_MMA(1, 0, At, B0); PG8_MMA(1, 1, At, B1); PG8_BAR; PG8_SCHED;
            PG8_LDB(B0, 1, 0); PG8_LDB(B1, 1, 1); PG8_SCHED; PG8_LDA(At, 1, 0); PG8_STAGE_A(PG8_SA(0, 1), a2, 1, last);
            PG8_WAIT_V(8); PG8_WAIT_L(0); PG8_BAR; PG8_MMA(0, 0, At, B0); PG8_MMA(0, 1, At, B1); PG8_BAR; PG8_SCHED;
            PG8_LDA(At, 1, 1); PG8_STAGE(PG8_SB(1, 0), b3, voffB); PG8_STAGE(PG8_SB(1, 1), b3 + hstep, voffB); PG8_STAGE_A(PG8_SA(1, 0), a3, 0, last);
            PG8_WAIT_V(8); PG8_WAIT_L(0); PG8_BAR; PG8_MMA(1, 0, At, B0); PG8_MMA(1, 1, At, B1); PG8_BAR; PG8_SCHED;
        }
        if constexpr (ALIGN_EPI) { if (wr == 0) PG8_BAR; }
        { int lo_ = lane; asm volatile("" : "+v"(lo_)); E(acc, cur, wr, wc, lo_ & 15, lo_ >> 4); }
        if (!has_next) break;
#pragma unroll
        for (int a = 0; a < 2; ++a)
#pragma unroll
            for (int b = 0; b < 2; ++b)
#pragma unroll
                for (int m = 0; m < 4; ++m)
#pragma unroll
                    for (int n = 0; n < 2; ++n) acc[a][b][m][n] = (f32x4){0.f, 0.f, 0.f, 0.f};
        cur = nxt; cA = nA; cB = nB; ++ui;
        if constexpr (ALIGN_EPI) { if (wr == 1) PG8_BAR; }
    }
    PG8_WAIT_V(0);
    if constexpr (!ALIGN_EPI) { if (wr == 0) PG8_BAR; }
    PG8_BAR;
#undef PG8_SA
#undef PG8_SB
#undef PG8_STAGE
#undef PG8_STAGE_A
#undef PG8_LD8
#undef PG8_LO
#undef PG8_HI
#undef PG8_LDA
#undef PG8_LDB
#undef PG8_MMA
#undef PG8_WAIT_V
#undef PG8_WAIT_L
#undef PG8_BAR
#undef PG8_SCHED
}
}
namespace fk {
using pg8::bf16_t; using pg8::bf16x8; using pg8::f32x4; using pg8::u32x4; using pg8::u32x2; using pg8::Unit; using pg8::cvt_pk_bf16; using pg8::bf_lo; using pg8::bf_hi;
#define LAS __attribute__((address_space(3)))
typedef float f32x16 __attribute__((ext_vector_type(16)));
typedef float f32x2 __attribute__((ext_vector_type(2)));
typedef short s16x4 __attribute__((ext_vector_type(4)));
constexpr int T = 16384, D = 1024, S = 2048, NB = 8, NE = 32, NIN = 4256;
constexpr int NWAVES = 8, NTHR = 512;
constexpr float ALPHA = 1.189207115002721f, LOG2E = 1.4426950408889634f;
constexpr float QA_SCALE = 0.125f * LOG2E;
constexpr float QB_SCALE = 0.10206207261596575f * LOG2E;
constexpr float WQ_SCALE = 64.f, WQ_INV = 1.f / 64.f;

constexpr size_t MiB = 1u << 20;
constexpr size_t WS_CTL = 0, CTL_ZERO_BYTES = 1 * MiB;
constexpr size_t WS_MODP = 1 * MiB, WS_MOD = 4 * MiB, WS_CS = 5 * MiB, WS_SSQQ = 7 * MiB, WS_SSQKV = 7 * MiB + 512 * 1024;
constexpr size_t WS_TE = 8 * MiB, WS_TW = 8 * MiB + 256 * 1024, WS_TP = 8 * MiB + 512 * 1024, WS_LISTS = 9 * MiB;
constexpr size_t WS_WIN = 12 * MiB, WS_WUQ = 21 * MiB, WS_WUKV = 22 * MiB, WS_WBA = 23 * MiB, WS_WBB = 24 * MiB, WS_WOUT = 25 * MiB;
constexpr size_t WS_WGU = 28 * MiB, WS_WD = 156 * MiB;
constexpr size_t WS_H1 = 220 * MiB, WS_QA = 252 * MiB, WS_KA = 268 * MiB, WS_VA = 284 * MiB, WS_CQ = 300 * MiB, WS_CKV = 312 * MiB, WS_KPE = 320 * MiB, WS_GA = 321 * MiB, WS_GB = 353 * MiB;
constexpr size_t WS_QB = 220 * MiB, WS_KB = 385 * MiB, WS_VB = 401 * MiB, WS_YA = 417 * MiB, WS_YB = 433 * MiB, WS_MG = 252 * MiB, WS_H2 = 353 * MiB, WS_HE = 220 * MiB, WS_YE = 28 * MiB;
constexpr size_t WS_END = 449 * MiB;
constexpr int NPAD_WIN = 4352;
constexpr int CW_BAR = 4096, CW_CNT = 8192;
constexpr int RING_BYTES = 131072, LDSX = RING_BYTES, LDS_BYTES = 147456;
constexpr int LX_MISC = LDSX, LX_CNT = LDSX + 256, LX_BASE = LDSX + 512, LX_BPRE = LDSX + 768, LX_NLOC = LDSX + 1024, LX_UTAB = LDSX + 1280, LX_GTAB = LDSX + 2048;

#define LDS_WAIT() asm volatile("s_waitcnt lgkmcnt(0)" ::: "memory")
#define VM_WAIT() asm volatile("s_waitcnt vmcnt(0)" ::: "memory")

#define XB_TMO      128
#define XB_XCNT(j)  (256  + 64 * (j))
#define XB_XSUB(j)  (1280 + 64 * (j))
#define XB_XGEN(j)  (2304 + 64 * (j))
#define XB_TOP      3328
#define XB_TOPGEN   3392
#define XCD_BAR_WORDS 3456
#define XB_SPIN_CAP (1u << 18)
__device__ __forceinline__ unsigned xb_ld(unsigned* p)              { return __hip_atomic_load(p, __ATOMIC_RELAXED, __HIP_MEMORY_SCOPE_AGENT); }
__device__ __forceinline__ unsigned xb_add(unsigned* p, unsigned v) { return __hip_atomic_fetch_add(p, v, __ATOMIC_RELAXED, __HIP_MEMORY_SCOPE_AGENT); }
__device__ __forceinline__ unsigned xb_xcc_id() { return (unsigned)__builtin_amdgcn_s_getreg((3 << 11) | 20) & 0xFu; }
#define XB_SPIN(cond, bar) do { unsigned _sp = 0; while (cond) { __builtin_amdgcn_s_sleep(1); \
    if ((++_sp & 255u) == 0u) { if (xb_ld(&(bar)[XB_TMO])) break; if (_sp > XB_SPIN_CAP) { atomicAdd(&(bar)[XB_TMO], 1u); break; } } } } while (0)
struct XcdBarrier { unsigned* bar; unsigned x; volatile LAS unsigned* st; };
__device__ __forceinline__ XcdBarrier xcd_barrier_post(unsigned* bar, volatile LAS unsigned* st) {
    XcdBarrier b; b.bar = bar; b.x = xb_xcc_id(); b.st = st;
    if (threadIdx.x == 0) (void)xb_add(&bar[XB_XCNT(b.x)], 1u);
    return b;
}
__device__ __forceinline__ void xcd_barrier_complete(unsigned* bar, unsigned x, unsigned& nloc, unsigned& nx) {
    const unsigned G = gridDim.x * gridDim.y * gridDim.z;
    unsigned sum, cnt, mine, sp = 0u;
    for (;;) {
        sum = 0u; cnt = 0u; mine = 0u;
#pragma unroll
        for (unsigned j = 0; j < 16; ++j) { const unsigned c = xb_ld(&bar[XB_XCNT(j)]); sum += c; cnt += (c > 0u) ? 1u : 0u; mine = (j == x) ? c : mine; }
        if (sum == G) break;
        __builtin_amdgcn_s_sleep(1);
        if ((++sp & 255u) == 0u) { if (xb_ld(&bar[XB_TMO])) break; if (sp > XB_SPIN_CAP) { atomicAdd(&bar[XB_TMO], 1u); break; } }
    }
    nloc = mine > 0u ? mine : 1u; nx = cnt > 0u ? cnt : 1u;
}
__device__ __forceinline__ void xcd_barrier(const XcdBarrier& b) {
    asm volatile("s_waitcnt vmcnt(0)" ::: "memory");
    __syncthreads();
    if (threadIdx.x == 0) {
        unsigned* bar = b.bar;
        __builtin_amdgcn_s_waitcnt(0);
        unsigned nloc = b.st[0], nx = b.st[1];
        if (nloc == 0u) { xcd_barrier_complete(bar, b.x, nloc, nx); b.st[0] = nloc; b.st[1] = nx; }
        const unsigned old = xb_add(&bar[XB_XSUB(b.x)], 1u);
        const unsigned gen = old / nloc;
        if (old + 1u == (gen + 1u) * nloc) {
            __builtin_amdgcn_fence(__ATOMIC_RELEASE, "agent");
            asm volatile("s_waitcnt vmcnt(0)" ::: "memory");
            const unsigned og = xb_add(&bar[XB_TOP], 1u);
            const unsigned tg = og / nx;
            if (og + 1u == (tg + 1u) * nx) xb_add(&bar[XB_TOPGEN], 1u);
            else XB_SPIN(xb_ld(&bar[XB_TOPGEN]) == tg, bar);
            __builtin_amdgcn_fence(__ATOMIC_ACQUIRE, "agent");
            xb_add(&bar[XB_XGEN(b.x)], 1u);
            asm volatile("s_waitcnt vmcnt(0)" ::: "memory");
        } else {
            XB_SPIN(xb_ld(&bar[XB_XGEN(b.x)]) == gen, bar);
            __builtin_amdgcn_fence(__ATOMIC_ACQUIRE, "agent");
            asm volatile("s_waitcnt vmcnt(0)" ::: "memory");
        }
    }
    __syncthreads();
}

struct KP { const float* in[26]; float* out; unsigned char* ws; int ph_lo, ph_hi; };

struct Frame {
    LAS unsigned char* lds; int tid, lane, wave, G, bx;
    const float *x, *c, *w_ada, *b_ada, *w_in, *rms_q, *w_uq, *rms_kv, *w_ukv, *rel_bias, *wba, *wbb, *w_out, *ln1_g, *ln1_b, *w_router, *b_router, *w_gate, *b_gate, *w_up, *b_up, *w_down, *b_down, *ln2_g, *ln2_b;
    const int* pos; float* out; unsigned char* ws;
};
__device__ __forceinline__ float wave_sum(float v) {
#pragma unroll
    for (int o = 1; o < 64; o <<= 1) v += __shfl_xor(v, o);
    return v;
}
__device__ __forceinline__ float fast_sigmoid(float x) { return __builtin_amdgcn_rcpf(1.f + __builtin_amdgcn_exp2f(-LOG2E * x)); }

template <class MapF>
__device__ __forceinline__ void transpose_item(const float* __restrict__ W, int K, int N, bf16_t* __restrict__ WT, MapF F, const float* __restrict__ kscale, LAS float* scr, int item, int lane) {
    const int nblk = N / 32, kb = item / nblk, nb = item % nblk, k0 = 64 * kb, n0 = 32 * nb;
#pragma unroll 8
    for (int i = 0; i < 32; ++i) { const int kk = 2 * i + (lane >> 5); float v = W[(size_t)(k0 + kk) * N + n0 + (lane & 31)]; if (kscale) v *= kscale[k0 + kk]; scr[kk * 33 + (lane & 31)] = v; }
    LDS_WAIT(); asm volatile("" ::: "memory");
    const int c = lane & 7;
#pragma unroll
    for (int j = 0; j < 4; ++j) { const int n = (lane >> 3) + 8 * j; const LAS float* s = scr + (8 * c) * 33 + n;
        u32x4 o; o.x = cvt_pk_bf16(s[0 * 33], s[1 * 33]); o.y = cvt_pk_bf16(s[2 * 33], s[3 * 33]); o.z = cvt_pk_bf16(s[4 * 33], s[5 * 33]); o.w = cvt_pk_bf16(s[6 * 33], s[7 * 33]);
        *(u32x4*)(WT + (size_t)F(n0 + n) * K + k0 + 8 * c) = o; }
    LDS_WAIT(); asm volatile("" ::: "memory");
}
__device__ __forceinline__ unsigned pk4_fp8(float a, float b, float c, float d) { int p = __builtin_amdgcn_cvt_pk_fp8_f32(a, b, 0, false); p = __builtin_amdgcn_cvt_pk_fp8_f32(c, d, p, true); return (unsigned)p; }
template <class MapF>
__device__ __forceinline__ void transpose_item_fp8(const float* __restrict__ W, int K, int N, unsigned char* __restrict__ WT, MapF F, float qs, LAS float* scr, int item, int lane) {
    const int nblk = N / 32, kb = item / nblk, nb = item % nblk, n0 = 32 * nb;
#pragma unroll 1
    for (int hf = 0; hf < 2; ++hf) {
        const int k0 = 128 * kb + 64 * hf;
#pragma unroll 8
        for (int i = 0; i < 32; ++i) { const int kk = 2 * i + (lane >> 5); scr[kk * 33 + (lane & 31)] = W[(size_t)(k0 + kk) * N + n0 + (lane & 31)] * qs; }
        LDS_WAIT(); asm volatile("" ::: "memory");
        const int c = lane & 7;
#pragma unroll
        for (int j = 0; j < 4; ++j) { const int n = (lane >> 3) + 8 * j; const LAS float* s = scr + (8 * c) * 33 + n;
            u32x2 o; o.x = pk4_fp8(s[0 * 33], s[1 * 33], s[2 * 33], s[3 * 33]); o.y = pk4_fp8(s[4 * 33], s[5 * 33], s[6 * 33], s[7 * 33]);
            *(u32x2*)(WT + (size_t)F(n0 + n) * K + k0 + 8 * c) = o; }
        LDS_WAIT(); asm volatile("" ::: "memory");
    }
}
struct MapId { __device__ int operator()(int n) const { return n; } };
struct MapWin { __device__ int operator()(int n) const {
    if (n < 1920) return n;
    if (n < 2176) return 2048 + (n - 1920);
    if (n < 2208) { const int i = n - 2176; return 1920 + 8 * ((i & 15) >> 2) + 4 * (i >> 4) + (i & 3); }
    if (n < 3232) return 2304 + (n - 2208);
    return 3328 + (n - 3232); } };
struct MapUq { __device__ int operator()(int n) const { const int h = n / 96, j = n - h * 96; return j < 64 ? h * 64 + j : 512 + h * 32 + (j - 64); } };
struct MapUkv { __device__ int operator()(int n) const { const int h = n >> 7, j = n & 127; return j < 64 ? h * 64 + j : 512 + h * 64 + (j - 64); } };
struct MapGU { int up; __device__ int operator()(int n) const { return 256 * (n >> 7) + (up ? 128 : 0) + (n & 127); } };

__device__ __forceinline__ void rope_cs(int pos, int i, float& cs, float& sn) {
    const double b4 = (i & 3) == 0 ? 1.0 : (i & 3) == 1 ? 0.5623413251903491 : (i & 3) == 2 ? 0.31622776601683794 : 0.17782794100389228;
    const double p10 = (i >> 2) == 0 ? 1.0 : (i >> 2) == 1 ? 0.1 : (i >> 2) == 2 ? 0.01 : 0.001;
    double t = (double)pos * (b4 * p10) * 0.15915494309189535;
    t -= __builtin_rint(t);
    const float tf = (float)t;
    sn = __builtin_amdgcn_sinf(tf); cs = __builtin_amdgcn_cosf(tf);
}

__device__ __forceinline__ void p0_prologue(Frame& F) {
    const int gw = F.bx * NWAVES + F.wave, NGW = F.G * NWAVES, lane = F.lane;
    float* modp = (float*)(F.ws + WS_MODP);
    for (int it = gw; it < 96 * 16; it += NGW) {
        const int cg = it % 96, ks = it / 96, m = cg * 64 + lane;
        float sc[8], acc[8];
#pragma unroll
        for (int b = 0; b < 8; ++b) { const float cv = F.c[b * D + ks * 64 + lane]; sc[b] = cv / (1.f + __expf(-cv)); acc[b] = 0.f; }
#pragma unroll 8
        for (int kk = 0; kk < 64; ++kk) { const float w = F.w_ada[(size_t)(ks * 64 + kk) * 6144 + m];
#pragma unroll
            for (int b = 0; b < 8; ++b) acc[b] += __int_as_float(__builtin_amdgcn_readlane(__float_as_int(sc[b]), kk)) * w; }
#pragma unroll
        for (int b = 0; b < 8; ++b) modp[(size_t)(ks * 8 + b) * 6144 + m] = acc[b];
    }
    LAS float* scr = (LAS float*)(F.lds + F.wave * 16384);
    constexpr int I_EXP = 32 * 3 * 256, I_WIN = 16 * 133, I_WUQ = 6 * 24, I_WUKV = 4 * 32, I_WB = 8 * 32, I_WOUT = 16 * 32;
    constexpr int NITEMS = I_EXP + I_WIN + I_WUQ + I_WUKV + 2 * I_WB + I_WOUT;
    for (int it = gw; it < NITEMS; it += NGW) {
        int r = it;
        if (r < I_EXP) { const int e = r / 768, q = r % 768, mat = q / 256, item = q % 256;
            if (mat == 0) { MapGU mp{0}; transpose_item_fp8(F.w_gate + (size_t)e * D * D, D, D, F.ws + WS_WGU + (size_t)e * 2048 * D, mp, WQ_SCALE, scr, item, lane); }
            else if (mat == 1) { MapGU mp{1}; transpose_item_fp8(F.w_up + (size_t)e * D * D, D, D, F.ws + WS_WGU + (size_t)e * 2048 * D, mp, WQ_SCALE, scr, item, lane); }
            else transpose_item_fp8(F.w_down + (size_t)e * D * D, D, D, F.ws + WS_WD + (size_t)e * D * D, MapId(), WQ_SCALE, scr, item, lane);
            continue; } r -= I_EXP;
        if (r < I_WIN) { transpose_item(F.w_in, D, NIN, (bf16_t*)(F.ws + WS_WIN), MapWin(), nullptr, scr, r, lane); continue; } r -= I_WIN;
        if (r < I_WUQ) { transpose_item(F.w_uq, 384, 768, (bf16_t*)(F.ws + WS_WUQ), MapUq(), F.rms_q, scr, r, lane); continue; } r -= I_WUQ;
        if (r < I_WUKV) { transpose_item(F.w_ukv, 256, 1024, (bf16_t*)(F.ws + WS_WUKV), MapUkv(), F.rms_kv, scr, r, lane); continue; } r -= I_WUKV;
        if (r < I_WB) { transpose_item(F.wba, 512, D, (bf16_t*)(F.ws + WS_WBA), MapId(), nullptr, scr, r, lane); continue; } r -= I_WB;
        if (r < I_WB) { transpose_item(F.wbb, 512, D, (bf16_t*)(F.ws + WS_WBB), MapId(), nullptr, scr, r, lane); continue; } r -= I_WB;
        transpose_item(F.w_out, D, D, (bf16_t*)(F.ws + WS_WOUT), MapId(), nullptr, scr, r, lane);
    }
    const int gt = F.bx * NTHR + F.tid, NGT = F.G * NTHR;
    f32x2* cs = (f32x2*)(F.ws + WS_CS);
    for (int i = gt; i < T * 16; i += NGT) { float c_, s_; rope_cs(F.pos[i >> 4], i & 15, c_, s_); cs[i] = (f32x2){c_, s_}; }
    u32x4* padp = (u32x4*)((bf16_t*)(F.ws + WS_WIN) + (size_t)1952 * D);
    for (int i = gt; i < 96 * D * 2 / 16; i += NGT) padp[i] = (u32x4){0u, 0u, 0u, 0u};
}

__device__ __forceinline__ void p1_h1(Frame& F) {
    const float* modp = (const float*)(F.ws + WS_MODP); float* mod = (float*)(F.ws + WS_MOD);
    for (int i = F.bx * NTHR + F.tid; i < 8 * 6144; i += F.G * NTHR) { const int m = i % 6144; float a = F.b_ada[m];
#pragma unroll
        for (int ks = 0; ks < 16; ++ks) a += modp[(size_t)ks * 8 * 6144 + i];
        mod[i] = a; }
    LAS float* sh = (LAS float*)F.lds; LAS float* sc = sh + 1024;
    bf16_t* H1 = (bf16_t*)(F.ws + WS_H1);
    for (int blk = F.bx; blk < T / 64; blk += F.G) {
        const int b = (blk * 64) / S;
        __syncthreads();
        for (int i = F.tid; i < 2048; i += NTHR) { float a = F.b_ada[i];
#pragma unroll
            for (int ks = 0; ks < 16; ++ks) a += modp[(size_t)(ks * 8 + b) * 6144 + i];
            sh[i] = a; }
        __syncthreads();
        for (int rr = F.wave; rr < 64; rr += NWAVES) {
            const int row = blk * 64 + rr;
            const f32x4* xr = (const f32x4*)(F.x + (size_t)row * D) + F.lane; u32x2* o = (u32x2*)(H1 + (size_t)row * D) + F.lane;
#pragma unroll
            for (int j = 0; j < 4; ++j) { const f32x4 v = xr[64 * j]; const int k = 4 * F.lane + 256 * j;
                const f32x4 s1 = *(const LAS f32x4*)(sh + k), c1 = *(const LAS f32x4*)(sc + k);
                u32x2 w; w.x = cvt_pk_bf16(v.x * (1.f + c1.x) + s1.x, v.y * (1.f + c1.y) + s1.y); w.y = cvt_pk_bf16(v.z * (1.f + c1.z) + s1.z, v.w * (1.f + c1.w) + s1.w); o[64 * j] = w; }
        }
    }
}
typedef f32x4 Acc[2][2][4][2];
__device__ __forceinline__ u32x4 pack8(const f32x4 a, const f32x4 b) { u32x4 w; w.x = cvt_pk_bf16(a[0], a[1]); w.y = cvt_pk_bf16(a[2], a[3]); w.z = cvt_pk_bf16(b[0], b[1]); w.w = cvt_pk_bf16(b[2], b[3]); return w; }
__device__ __forceinline__ size_t kimg_idx(int r, int h, int chunk) { const int b = r >> 11, s = r & 2047; return ((size_t)((b * 8 + h) * 32 + (s >> 6)) * 4096) + chunk * 512 + (s & 63) * 8; }
__device__ __forceinline__ size_t vimg_idx(int r, int h, int g) { const int b = r >> 11, s = r & 2047, key = s & 63; return ((size_t)((b * 8 + h) * 32 + (s >> 6)) * 4096) + (g >> 2) * 2048 + (key >> 3) * 256 + (key & 7) * 32 + (g & 3) * 8; }
__device__ __forceinline__ size_t kpe_idx(int r, int chunk) { const int b = r >> 11, s = r & 2047; return ((size_t)(b * 32 + (s >> 6)) * 2048) + chunk * 512 + (s & 63) * 8; }

struct EpiZ {
    static constexpr bool PERM = true;
    bf16_t *QA, *KA, *VA, *CQ, *CKV, *KPE, *GA, *GB; float *SSQQ, *SSQKV; const f32x2* cs;
    __device__ __forceinline__ void operator()(const Acc& acc, const Unit& u, int wr, int wc, int fr, int fq) const {
        const int pn = u.pn, row0 = u.pm * 256 + wr * 64 + fr;
#pragma unroll
        for (int ai = 0; ai < 2; ++ai)
#pragma unroll
            for (int m = 0; m < 4; ++m) {
                const int r = row0 + ai * 128 + m * 16;
                if (pn < 2) {
#pragma unroll
                    for (int bj = 0; bj < 2; ++bj) { const int c = pn * 256 + bj * 128 + wc * 32 + 8 * fq;
                        *(u32x4*)(QA + (size_t)r * 512 + c) = pack8(acc[ai][bj][m][0] * QA_SCALE, acc[ai][bj][m][1] * QA_SCALE); }
                } else if (pn < 4) {
#pragma unroll
                    for (int bj = 0; bj < 2; ++bj) { const int c = (pn - 2) * 256 + bj * 128 + wc * 32 + 8 * fq;
                        *(u32x4*)(KA + kimg_idx(r, c >> 6, (c & 63) >> 3)) = pack8(acc[ai][bj][m][0], acc[ai][bj][m][1]); }
                } else if (pn < 6) {
#pragma unroll
                    for (int bj = 0; bj < 2; ++bj) { const int c = (pn - 4) * 256 + bj * 128 + wc * 32 + 8 * fq;
                        *(u32x4*)(VA + vimg_idx(r, c >> 6, (c & 63) >> 3)) = pack8(acc[ai][bj][m][0], acc[ai][bj][m][1]); }
                } else if (pn == 6 || pn == 8) {
                    float s = 0.f;
#pragma unroll
                    for (int bj = 0; bj < 2; ++bj) { const int c = bj * 128 + wc * 32 + 8 * fq; const f32x4 a = acc[ai][bj][m][0], b = acc[ai][bj][m][1];
                        s += (a[0] * a[0] + a[1] * a[1]) + (a[2] * a[2] + a[3] * a[3]) + (b[0] * b[0] + b[1] * b[1]) + (b[2] * b[2] + b[3] * b[3]);
                        if (pn == 6) *(u32x4*)(CQ + (size_t)r * 384 + c) = pack8(a, b); else *(u32x4*)(CKV + (size_t)r * 256 + c) = pack8(a, b); }
                    s += __shfl_xor(s, 16); s += __shfl_xor(s, 32);
                    if (fq == 0) { if (pn == 6) SSQQ[(size_t)r * 8 + wc] = s; else SSQKV[(size_t)r * 4 + wc] = s; }
                } else if (pn == 7) {
                    { const int c = wc * 32 + 8 * fq; const f32x4 a = acc[ai][0][m][0], b = acc[ai][0][m][1];
                      float s = (a[0] * a[0] + a[1] * a[1]) + (a[2] * a[2] + a[3] * a[3]) + (b[0] * b[0] + b[1] * b[1]) + (b[2] * b[2] + b[3] * b[3]);
                      *(u32x4*)(CQ + (size_t)r * 384 + 256 + c) = pack8(a, b);
                      s += __shfl_xor(s, 16); s += __shfl_xor(s, 32);
                      if (fq == 0) SSQQ[(size_t)r * 8 + 4 + wc] = s; }
                    if (wc == 0) {
                        const f32x4 x1 = acc[ai][1][m][0], x2 = acc[ai][1][m][1]; f32x4 o1, o2;
#pragma unroll
                        for (int j = 0; j < 4; ++j) { const f32x2 c_ = cs[(size_t)r * 16 + 4 * fq + j]; o1[j] = x1[j] * c_.x - x2[j] * c_.y; o2[j] = x2[j] * c_.x + x1[j] * c_.y; }
                        *(u32x4*)(KPE + kpe_idx(r, fq)) = pack8(o1, o2);
                    }
                } else {
                    bf16_t* G = pn < 13 ? GA : GB; const int cb = (pn < 13 ? pn - 9 : pn - 13) * 256;
#pragma unroll
                    for (int bj = 0; bj < 2; ++bj) { const int c = cb + bj * 128 + wc * 32 + 8 * fq; f32x4 a = acc[ai][bj][m][0], b = acc[ai][bj][m][1];
#pragma unroll
                        for (int j = 0; j < 4; ++j) { a[j] = fast_sigmoid(a[j]); b[j] = fast_sigmoid(b[j]); }
                        *(u32x4*)(G + (size_t)r * D + c) = pack8(a, b); }
                }
            }
    }
};

struct EpiQB {
    static constexpr bool PERM = false;
    bf16_t* QB; const float* SSQQ; const f32x2* cs;
    __device__ __forceinline__ void operator()(const Acc& acc, const Unit& u, int wr, int wc, int fr, int fq) const {
        const int pn = u.pn, row0 = u.pm * 256 + wr * 64 + fr;
#pragma unroll
        for (int ai = 0; ai < 2; ++ai)
#pragma unroll
            for (int m = 0; m < 4; ++m) {
                const int r = row0 + ai * 128 + m * 16;
                const f32x4 s0 = *(const f32x4*)(SSQQ + (size_t)r * 8), s1 = *(const f32x4*)(SSQQ + (size_t)r * 8 + 4);
                const float ss = ((s0[0] + s0[1]) + (s0[2] + s0[3])) + ((s1[0] + s1[1]) + (s1[2] + s1[3]));
                const float rinv = QB_SCALE / sqrtf(ss * (1.f / 384.f) + 1e-6f);
                if (pn < 2) {
#pragma unroll
                    for (int bj = 0; bj < 2; ++bj)
#pragma unroll
                        for (int n = 0; n < 2; ++n) { const int c = pn * 256 + bj * 128 + wc * 32 + n * 16 + 4 * fq; const f32x4 a = acc[ai][bj][m][n] * rinv;
                            u32x2 w; w.x = cvt_pk_bf16(a[0], a[1]); w.y = cvt_pk_bf16(a[2], a[3]);
                            *(u32x2*)(QB + (size_t)r * 768 + (c >> 6) * 96 + (c & 63)) = w; }
                } else {
#pragma unroll
                    for (int bj = 0; bj < 2; ++bj) { const int head = bj * 4 + wc; const f32x4 x1 = acc[ai][bj][m][0] * rinv, x2 = acc[ai][bj][m][1] * rinv; f32x4 o1, o2;
#pragma unroll
                        for (int j = 0; j < 4; ++j) { const f32x2 c_ = cs[(size_t)r * 16 + 4 * fq + j]; o1[j] = x1[j] * c_.x - x2[j] * c_.y; o2[j] = x2[j] * c_.x + x1[j] * c_.y; }
                        *(u32x4*)(QB + (size_t)r * 768 + head * 96 + 64 + 8 * fq) = pack8(o1, o2); }
                }
                asm volatile("" ::: "memory");
            }
    }
};

struct EpiKVB {
    static constexpr bool PERM = true;
    bf16_t *KB, *VB; const float* SSQKV;
    __device__ __forceinline__ void operator()(const Acc& acc, const Unit& u, int wr, int wc, int fr, int fq) const {
        const int pn = u.pn, row0 = u.pm * 256 + wr * 64 + fr;
#pragma unroll
        for (int ai = 0; ai < 2; ++ai)
#pragma unroll
            for (int m = 0; m < 4; ++m) {
                const int r = row0 + ai * 128 + m * 16;
                const f32x4 s0 = *(const f32x4*)(SSQKV + (size_t)r * 4);
                const float rinv = 1.f / sqrtf(((s0[0] + s0[1]) + (s0[2] + s0[3])) * (1.f / 256.f) + 1e-6f);
#pragma unroll
                for (int bj = 0; bj < 2; ++bj) { const int c = (pn & 1) * 256 + bj * 128 + wc * 32 + 8 * fq; const u32x4 w = pack8(acc[ai][bj][m][0] * rinv, acc[ai][bj][m][1] * rinv);
                    if (pn < 2) *(u32x4*)(KB + kimg_idx(r, c >> 6, (c & 63) >> 3)) = w; else *(u32x4*)(VB + vimg_idx(r, c >> 6, (c & 63) >> 3)) = w; }
            }
    }
};

template <int SECOND> struct EpiMG {
    static constexpr bool PERM = true;
    bf16_t* MG; const bf16_t* GT;
    __device__ __forceinline__ void operator()(const Acc& acc, const Unit& u, int wr, int wc, int fr, int fq) const {
        const int row0 = u.pm * 256 + wr * 64 + fr;
#pragma unroll
        for (int ai = 0; ai < 2; ++ai)
#pragma unroll
            for (int m = 0; m < 4; ++m) {
                const int r = row0 + ai * 128 + m * 16;
#pragma unroll
                for (int bj = 0; bj < 2; ++bj) { const size_t off = (size_t)r * D + u.pn * 256 + bj * 128 + wc * 32 + 8 * fq;
                    const u32x4 g = *(const u32x4*)(GT + off); f32x4 a = acc[ai][bj][m][0], b = acc[ai][bj][m][1];
                    a[0] *= bf_lo(g.x); a[1] *= bf_hi(g.x); a[2] *= bf_lo(g.y); a[3] *= bf_hi(g.y); b[0] *= bf_lo(g.z); b[1] *= bf_hi(g.z); b[2] *= bf_lo(g.w); b[3] *= bf_hi(g.w);
                    if (SECOND) { const u32x4 p = *(const u32x4*)(MG + off);
                        a[0] += bf_lo(p.x); a[1] += bf_hi(p.x); a[2] += bf_lo(p.y); a[3] += bf_hi(p.y); b[0] += bf_lo(p.z); b[1] += bf_hi(p.z); b[2] += bf_lo(p.w); b[3] += bf_hi(p.w); }
                    *(u32x4*)(MG + off) = pack8(a, b); }
            }
    }
};

struct EpiR1 {
    static constexpr bool PERM = false;
    float* R1; const float* x; const float* mod;
    __device__ __forceinline__ void operator()(const Acc& acc, const Unit& u, int wr, int wc, int fr, int fq) const {
        const int row0 = u.pm * 256 + wr * 64 + fr;
#pragma unroll
        for (int ai = 0; ai < 2; ++ai)
#pragma unroll
            for (int m = 0; m < 4; ++m) {
                const int r = row0 + ai * 128 + m * 16; const float* gp = mod + (r >> 11) * 6144 + 2048;
#pragma unroll
                for (int bj = 0; bj < 2; ++bj)
#pragma unroll
                    for (int n = 0; n < 2; ++n) { const int c = u.pn * 256 + bj * 128 + wc * 32 + n * 16 + 4 * fq;
                        const f32x4 xv = *(const f32x4*)(x + (size_t)r * D + c), g = *(const f32x4*)(gp + c);
                        *(f32x4*)(R1 + (size_t)r * D + c) = xv * ALPHA + g * acc[ai][bj][m][n]; }
            }
    }
};

struct EpiGU {
    static constexpr bool PERM = true;
    unsigned char* HE; const float* b_gate; const float* b_up;
    __device__ __forceinline__ void operator()(const Acc& acc, const Unit& u, int wr, int wc, int fr, int fq) const {
        const int e = u.x2, f0 = u.pn * 128 + wc * 32 + 8 * fq;
        const f32x4 bg0 = *(const f32x4*)(b_gate + e * D + f0), bg1 = *(const f32x4*)(b_gate + e * D + f0 + 4), bu0 = *(const f32x4*)(b_up + e * D + f0), bu1 = *(const f32x4*)(b_up + e * D + f0 + 4);
#pragma unroll
        for (int ai = 0; ai < 2; ++ai)
#pragma unroll
            for (int m = 0; m < 4; ++m) {
                const int rl = ai * 128 + wr * 64 + m * 16 + fr;
                f32x4 g0 = acc[ai][0][m][0] * WQ_INV + bg0, g1 = acc[ai][0][m][1] * WQ_INV + bg1, u0 = acc[ai][1][m][0] * WQ_INV + bu0, u1 = acc[ai][1][m][1] * WQ_INV + bu1;
#pragma unroll
                for (int j = 0; j < 4; ++j) {
                    const float ga = fminf(g0[j], 7.f), gb = fminf(g1[j], 7.f), ua = fminf(fmaxf(u0[j], -7.f), 7.f), ub = fminf(fmaxf(u1[j], -7.f), 7.f);
                    g0[j] = (ua + 1.f) * ga * fast_sigmoid(1.702f * ga); g1[j] = (ub + 1.f) * gb * fast_sigmoid(1.702f * gb); }
                if (rl < u.x1) { u32x2 w; w.x = pk4_fp8(g0[0], g0[1], g0[2], g0[3]); w.y = pk4_fp8(g1[0], g1[1], g1[2], g1[3]); *(u32x2*)(HE + (size_t)(u.x0 + rl) * D + f0) = w; }
            }
    }
};

struct EpiDown {
    static constexpr bool PERM = true;
    bf16_t* YE; const float* b_down;
    __device__ __forceinline__ void operator()(const Acc& acc, const Unit& u, int wr, int wc, int fr, int fq) const {
        const int e = u.x2;
#pragma unroll
        for (int bj = 0; bj < 2; ++bj) { const int c = u.pn * 256 + bj * 128 + wc * 32 + 8 * fq;
            const f32x4 b0 = *(const f32x4*)(b_down + e * D + c), b1 = *(const f32x4*)(b_down + e * D + c + 4);
#pragma unroll
            for (int ai = 0; ai < 2; ++ai)
#pragma unroll
                for (int m = 0; m < 4; ++m) { const int rl = ai * 128 + wr * 64 + m * 16 + fr;
                    if (rl < u.x1) *(u32x4*)(YE + (size_t)(u.x0 + rl) * D + c) = pack8(acc[ai][bj][m][0] * WQ_INV + b0, acc[ai][bj][m][1] * WQ_INV + b1); } }
    }
};

struct GroupSched {
    const LAS int* utab; const LAS unsigned* gtab; const char* A; const char* B; size_t bstride; int K; int nloc; int gather;
    __device__ bool next(int i, Unit& u) const {
        if (i >= nloc) return false;
        const int e = __builtin_amdgcn_readfirstlane(utab[i * 8 + 0]), rb = __builtin_amdgcn_readfirstlane(utab[i * 8 + 1]), nv = __builtin_amdgcn_readfirstlane(utab[i * 8 + 2]), pn = __builtin_amdgcn_readfirstlane(utab[i * 8 + 3]);
        u.A = gather ? A : A + (size_t)rb * K * 2; u.B = B + (size_t)e * bstride + (size_t)pn * 256 * K * 2; u.pm = 0; u.pn = pn; u.x0 = rb; u.x1 = nv; u.x2 = e; u.slot = i; return true;
    }
    __device__ __forceinline__ unsigned goff(int slot, int r) const { return gtab[slot * 256 + r]; }
};
__device__ __forceinline__ int build_group_tables(Frame& F, int NPN, bool gather) {
    LAS int* cntL = (LAS int*)(F.lds + LX_CNT); LAS int* baseL = (LAS int*)(F.lds + LX_BASE); LAS int* bpre = (LAS int*)(F.lds + LX_BPRE); LAS int* nlocL = (LAS int*)(F.lds + LX_NLOC);
    LAS int* utab = (LAS int*)(F.lds + LX_UTAB); LAS unsigned* gtab = (LAS unsigned*)(F.lds + LX_GTAB);
    const int* cnt = (const int*)(F.ws + WS_CTL) + CW_CNT; const int* lists = (const int*)(F.ws + WS_LISTS);
    __syncthreads();
    if (F.tid < NE) cntL[F.tid] = cnt[F.tid];
    __syncthreads();
    if (F.tid == 0) { int s = 0, bs = 0; for (int e = 0; e < NE; ++e) { baseL[e] = s; bpre[e] = bs; s += cntL[e]; bs += (cntL[e] + 255) >> 8; } baseL[NE] = s; bpre[NE] = bs;
        const int total = bs * NPN; int nl = total > F.bx ? (total - F.bx + F.G - 1) / F.G : 0; if (nl > 10) nl = 10; nlocL[0] = nl; }
    __syncthreads();
    const int nloc = nlocL[0];
    if (F.tid < nloc) { const int ug = F.tid * F.G + F.bx, bi = ug / NPN, pn = ug - bi * NPN; int e = 0;
        for (int q = 1; q < NE; ++q) if (bpre[q] <= bi) e = q;
        const int jb = bi - bpre[e]; int nv = cntL[e] - 256 * jb; nv = nv > 256 ? 256 : nv;
        utab[F.tid * 8 + 0] = e; utab[F.tid * 8 + 1] = baseL[e] + 256 * jb; utab[F.tid * 8 + 2] = nv; utab[F.tid * 8 + 3] = pn; utab[F.tid * 8 + 4] = jb; }
    __syncthreads();
    if (gather) {
        for (int i = F.tid; i < nloc * 256; i += NTHR) { const int sl = i >> 8, r = i & 255; const int e = utab[sl * 8 + 0], nv = utab[sl * 8 + 2], jb = utab[sl * 8 + 4];
            const int tok = lists[e * T + 256 * jb + (r < nv ? r : 0)]; gtab[i] = (unsigned)tok * 1024u; }
        __syncthreads();
    }
    return nloc;
}
constexpr int ATT_KOFF = 0, ATT_PEOFF = 8192, ATT_VOFF = 12288, ATT_BUF = 20480, ATT_BIAS = 2 * ATT_BUF;
typedef short v4i16_t __attribute__((ext_vector_type(4)));
__device__ __forceinline__ s16x4 vtr(const LAS unsigned char* p) { return __builtin_bit_cast(s16x4, __builtin_amdgcn_ds_read_tr16_b64_v4i16((LAS v4i16_t*)p)); }

template <int KS, bool BAND>
__device__ __forceinline__ void attn_unit(Frame& F, int b, int h, int qb, const bf16_t* __restrict__ Q, int qpitch, int qhd, const bf16_t* __restrict__ Kimg, const bf16_t* __restrict__ PEimg, const bf16_t* __restrict__ Vimg,
                                          bf16_t* __restrict__ Y, const float* __restrict__ rel_bias) {
    const int tid = F.tid, lane = F.lane, w = F.wave, r32 = lane & 31, hi = lane >> 5;
    LAS unsigned char* lds = F.lds;
    const int c0 = 4 * qb, cw = c0 + (w >> 1);
    const int t_lo = BAND ? (c0 - 8 < 0 ? 0 : c0 - 8) : 0, t_hi = c0 + 3;
    const bf16_t* Kt = Kimg + (size_t)((b * 8 + h) * 32) * 4096; const bf16_t* Vt = Vimg + (size_t)((b * 8 + h) * 32) * 4096; const bf16_t* Pt = PEimg + (size_t)(b * 32) * 2048;
    __syncthreads();
    if (BAND) { LAS float* bl = (LAS float*)(lds + ATT_BIAS); for (int i = tid; i < 257; i += NTHR) bl[i] = rel_bias[h * 257 + i] * LOG2E; }
    const int qrow = b * S + qb * 256 + w * 32 + r32;
    bf16x8 qf[KS];
#pragma unroll
    for (int ks = 0; ks < KS; ++ks) qf[ks] = *(const bf16x8*)(Q + (size_t)qrow * qpitch + h * qhd + ks * 16 + hi * 8);
    u32x4 sk, sv, sp;
    { const int t = t_lo; sk = *(const u32x4*)(Kt + (size_t)t * 4096 + tid * 8); sv = *(const u32x4*)(Vt + (size_t)t * 4096 + tid * 8); if (KS == 6 && tid < 256) sp = *(const u32x4*)(Pt + (size_t)t * 2048 + tid * 8);
      *(LAS u32x4*)(lds + ATT_KOFF + tid * 16) = sk; *(LAS u32x4*)(lds + ATT_VOFF + tid * 16) = sv; if (KS == 6 && tid < 256) *(LAS u32x4*)(lds + ATT_PEOFF + tid * 16) = sp; }
    __syncthreads();
    f32x16 o0 = {}, o1 = {}; float mrow = -1e30f, lsum = 0.f;
    const int vb = ((lane >> 4) & 1) * 32 + (lane & 3) * 8 + (4 * hi + ((lane & 15) >> 2)) * 64;
    for (int t = t_lo; t <= t_hi; ++t) {
        const int cur = (t - t_lo) & 1; LAS unsigned char* buf = lds + cur * ATT_BUF; LAS unsigned char* nbuf = lds + (cur ^ 1) * ATT_BUF;
        const bool more = t < t_hi;
        if (more) { sk = *(const u32x4*)(Kt + (size_t)(t + 1) * 4096 + tid * 8); sv = *(const u32x4*)(Vt + (size_t)(t + 1) * 4096 + tid * 8); if (KS == 6 && tid < 256) sp = *(const u32x4*)(Pt + (size_t)(t + 1) * 2048 + tid * 8); }
        const bool active = BAND ? (t <= cw && t >= cw - 8) : (t <= cw);
        if (active) {
            f32x16 p0 = {}, p1 = {};
#pragma unroll
            for (int ks = 0; ks < KS; ++ks) {
                const LAS unsigned char* kb = (ks < 4) ? (buf + ATT_KOFF + (2 * ks + hi) * 1024 + r32 * 16) : (buf + ATT_PEOFF + (2 * (ks - 4) + hi) * 1024 + r32 * 16);
                const bf16x8 k0 = *(const LAS bf16x8*)kb, k1 = *(const LAS bf16x8*)(kb + 512);
                p0 = __builtin_amdgcn_mfma_f32_32x32x16_bf16(k0, qf[ks], p0, 0, 0, 0); p1 = __builtin_amdgcn_mfma_f32_32x32x16_bf16(k1, qf[ks], p1, 0, 0, 0);
            }
            if (BAND) {
                const LAS float* bl = (const LAS float*)(lds + ATT_BIAS); const int dl = cw - t;
                if (dl >= 3) { const float bc = bl[256];
#pragma unroll
                    for (int r = 0; r < 16; ++r) { p0[r] += bc; p1[r] += bc; } }
                else { const int base = 64 * dl + 32 * (w & 1) + r32 - 4 * hi + 128;
#pragma unroll
                    for (int r = 0; r < 16; ++r) { int i0 = base - ((r & 3) + 8 * (r >> 2)); int i1 = i0 - 32; i0 = i0 > 256 ? 256 : i0; i1 = i1 > 256 ? 256 : i1; p0[r] += bl[i0]; p1[r] += bl[i1]; } }
            }
            float mx = fmaxf(p0[0], p1[0]);
#pragma unroll
            for (int r = 1; r < 16; ++r) mx = fmaxf(mx, fmaxf(p0[r], p1[r]));
            mx = fmaxf(mx, __shfl_xor(mx, 32));
            const float mn = fmaxf(mrow, mx), al = __builtin_amdgcn_exp2f(mrow - mn); mrow = mn;
            float rs = 0.f;
#pragma unroll
            for (int r = 0; r < 16; ++r) { p0[r] = __builtin_amdgcn_exp2f(p0[r] - mn); p1[r] = __builtin_amdgcn_exp2f(p1[r] - mn); rs += p0[r] + p1[r]; }
            lsum = lsum * al + rs;
#pragma unroll
            for (int r = 0; r < 16; ++r) { o0[r] *= al; o1[r] *= al; }
            u32x4 pw[4];
            pw[0] = (u32x4){cvt_pk_bf16(p0[0], p0[1]), cvt_pk_bf16(p0[2], p0[3]), cvt_pk_bf16(p0[4], p0[5]), cvt_pk_bf16(p0[6], p0[7])};
            pw[1] = (u32x4){cvt_pk_bf16(p0[8], p0[9]), cvt_pk_bf16(p0[10], p0[11]), cvt_pk_bf16(p0[12], p0[13]), cvt_pk_bf16(p0[14], p0[15])};
            pw[2] = (u32x4){cvt_pk_bf16(p1[0], p1[1]), cvt_pk_bf16(p1[2], p1[3]), cvt_pk_bf16(p1[4], p1[5]), cvt_pk_bf16(p1[6], p1[7])};
            pw[3] = (u32x4){cvt_pk_bf16(p1[8], p1[9]), cvt_pk_bf16(p1[10], p1[11]), cvt_pk_bf16(p1[12], p1[13]), cvt_pk_bf16(p1[14], p1[15])};
            const LAS unsigned char* vbase = buf + ATT_VOFF + vb;
#pragma unroll
            for (int ks4 = 0; ks4 < 4; ++ks4) {
                const s16x4 a0 = vtr(vbase + ks4 * 1024), a1 = vtr(vbase + ks4 * 1024 + 512), c0_ = vtr(vbase + 4096 + ks4 * 1024), c1_ = vtr(vbase + 4096 + ks4 * 1024 + 512);
                const bf16x8 v0 = (bf16x8){a0[0], a0[1], a0[2], a0[3], a1[0], a1[1], a1[2], a1[3]}, v1 = (bf16x8){c0_[0], c0_[1], c0_[2], c0_[3], c1_[0], c1_[1], c1_[2], c1_[3]};
                const bf16x8 pf = __builtin_bit_cast(bf16x8, pw[ks4]);
                o0 = __builtin_amdgcn_mfma_f32_32x32x16_bf16(v0, pf, o0, 0, 0, 0); o1 = __builtin_amdgcn_mfma_f32_32x32x16_bf16(v1, pf, o1, 0, 0, 0);
            }
        }
        if (more) { *(LAS u32x4*)(nbuf + ATT_KOFF + tid * 16) = sk; *(LAS u32x4*)(nbuf + ATT_VOFF + tid * 16) = sv; if (KS == 6 && tid < 256) *(LAS u32x4*)(nbuf + ATT_PEOFF + tid * 16) = sp; }
        __syncthreads();
    }
    lsum += __shfl_xor(lsum, 32);
    const float il = 1.f / lsum;
    bf16_t* yo = Y + (size_t)qrow * 512 + h * 64;
#pragma unroll
    for (int g = 0; g < 4; ++g) {
        u32x2 w0, w1; w0.x = cvt_pk_bf16(o0[4 * g] * il, o0[4 * g + 1] * il); w0.y = cvt_pk_bf16(o0[4 * g + 2] * il, o0[4 * g + 3] * il);
        w1.x = cvt_pk_bf16(o1[4 * g] * il, o1[4 * g + 1] * il); w1.y = cvt_pk_bf16(o1[4 * g + 2] * il, o1[4 * g + 3] * il);
        *(u32x2*)(yo + 8 * g + 4 * hi) = w0; *(u32x2*)(yo + 32 + 8 * g + 4 * hi) = w1;
    }
}

__device__ __forceinline__ void p4_attention(Frame& F) {
    const int vcu = (F.G % 8 == 0) ? (F.bx % 8) * (F.G / 8) + F.bx / 8 : F.bx;
    const bf16_t* QA = (const bf16_t*)(F.ws + WS_QA); const bf16_t* KA = (const bf16_t*)(F.ws + WS_KA); const bf16_t* VA = (const bf16_t*)(F.ws + WS_VA);
    const bf16_t* QB = (const bf16_t*)(F.ws + WS_QB); const bf16_t* KB = (const bf16_t*)(F.ws + WS_KB); const bf16_t* VB = (const bf16_t*)(F.ws + WS_VB); const bf16_t* KPE = (const bf16_t*)(F.ws + WS_KPE);
    bf16_t* YA = (bf16_t*)(F.ws + WS_YA); bf16_t* YB = (bf16_t*)(F.ws + WS_YB);
    for (int v = vcu; v < 256; v += F.G) {
        const int bh = v >> 2, s = v & 3, b = bh >> 3, h = bh & 7;
        attn_unit<6, false>(F, b, h, s, QB, 768, 96, KB, KPE, VB, YB, nullptr);
        attn_unit<6, false>(F, b, h, 7 - s, QB, 768, 96, KB, KPE, VB, YB, nullptr);
        attn_unit<4, true>(F, b, h, s, QA, 512, 64, KA, KPE, VA, YA, F.rel_bias);
        attn_unit<4, true>(F, b, h, 7 - s, QA, 512, 64, KA, KPE, VA, YA, F.rel_bias);
    }
    __syncthreads();
}

constexpr int P7_TE = LX_GTAB, P7_TW = LX_GTAB + 1024, P7_LR = LX_GTAB + 2048, P7_LCNT = LX_GTAB + 3072, P7_GBASE = LX_GTAB + 3328;
__device__ __forceinline__ void p7_ln_router(Frame& F) {
    LAS float* WT = (LAS float*)F.lds;
    LAS int* teL = (LAS int*)(F.lds + P7_TE); LAS float* twL = (LAS float*)(F.lds + P7_TW); LAS int* lrL = (LAS int*)(F.lds + P7_LR); LAS int* lcnt = (LAS int*)(F.lds + P7_LCNT); LAS int* gbase = (LAS int*)(F.lds + P7_GBASE);
    const float* mod = (const float*)(F.ws + WS_MOD); unsigned char* H2 = F.ws + WS_H2;
    int* cnt = (int*)(F.ws + WS_CTL) + CW_CNT; int* lists = (int*)(F.ws + WS_LISTS); int* TE = (int*)(F.ws + WS_TE); float* TW = (float*)(F.ws + WS_TW); int* TP = (int*)(F.ws + WS_TP);
    __syncthreads();
    for (int i = F.tid; i < 1024 * 8; i += NTHR) { const int k = i >> 3, e4 = (i & 7) * 4; const f32x4 v = *(const f32x4*)(F.w_router + (size_t)k * 32 + e4);
        WT[(e4 + 0) * 1024 + k] = v.x; WT[(e4 + 1) * 1024 + k] = v.y; WT[(e4 + 2) * 1024 + k] = v.z; WT[(e4 + 3) * 1024 + k] = v.w; }
    for (int blk = F.bx; blk < T / 64; blk += F.G) {
        const int b = (blk * 64) / S; const float* sh2 = mod + b * 6144 + 3072; const float* sc2 = mod + b * 6144 + 4096;
        __syncthreads();
        if (F.tid < NE) lcnt[F.tid] = 0;
        __syncthreads();
        for (int rr = F.wave; rr < 64; rr += NWAVES) {
            const int row = blk * 64 + rr, lane = F.lane;
            f32x4* xr = (f32x4*)(F.out + (size_t)row * D) + lane;
            f32x4 v[4]; float s = 0.f;
#pragma unroll
            for (int j = 0; j < 4; ++j) { v[j] = xr[64 * j]; s += (v[j].x + v[j].y) + (v[j].z + v[j].w); }
            const float mean = wave_sum(s) * (1.f / D); float s2 = 0.f;
#pragma unroll
            for (int j = 0; j < 4; ++j) { v[j] = v[j] - mean; s2 += (v[j].x * v[j].x + v[j].y * v[j].y) + (v[j].z * v[j].z + v[j].w * v[j].w); }
            const float rstd = 1.f / sqrtf(wave_sum(s2) * (1.f / D) + 1e-5f);
            unsigned* ho = (unsigned*)(H2 + (size_t)row * D) + lane;
#pragma unroll
            for (int j = 0; j < 4; ++j) { const int k = 4 * lane + 256 * j; const f32x4 gg = *(const f32x4*)(F.ln1_g + k), bb = *(const f32x4*)(F.ln1_b + k);
                v[j] = v[j] * rstd * gg + bb; xr[64 * j] = v[j];
                const f32x4 c2 = *(const f32x4*)(sc2 + k), s2v = *(const f32x4*)(sh2 + k);
                v[j] = v[j] * (c2 + 1.f) + s2v;
                ho[64 * j] = pk4_fp8(v[j].x, v[j].y, v[j].z, v[j].w); }
            float a[32];
#pragma unroll
            for (int e = 0; e < 32; ++e) { float t_ = 0.f;
#pragma unroll
                for (int j = 0; j < 4; ++j) { const f32x4 wv = *(const LAS f32x4*)(WT + e * 1024 + 4 * lane + 256 * j); t_ += (v[j].x * wv.x + v[j].y * wv.y) + (v[j].z * wv.z + v[j].w * wv.w); }
                a[e] = t_; }
            float c16[16];
#pragma unroll
            for (int i = 0; i < 16; ++i) { const bool up = (lane & 32) != 0; const float keep = up ? a[16 + i] : a[i], send = up ? a[i] : a[16 + i]; c16[i] = keep + __shfl_xor(send, 32); }
            float c8[8];
#pragma unroll
            for (int i = 0; i < 8; ++i) { const bool up = (lane & 16) != 0; const float keep = up ? c16[8 + i] : c16[i], send = up ? c16[i] : c16[8 + i]; c8[i] = keep + __shfl_xor(send, 16); }
            float c4[4];
#pragma unroll
            for (int i = 0; i < 4; ++i) { const bool up = (lane & 8) != 0; const float keep = up ? c8[4 + i] : c8[i], send = up ? c8[i] : c8[4 + i]; c4[i] = keep + __shfl_xor(send, 8); }
            float c2_[2];
#pragma unroll
            for (int i = 0; i < 2; ++i) { const bool up = (lane & 4) != 0; const float keep = up ? c4[2 + i] : c4[i], send = up ? c4[i] : c4[2 + i]; c2_[i] = keep + __shfl_xor(send, 4); }
            float c1; { const bool up = (lane & 2) != 0; const float keep = up ? c2_[1] : c2_[0], send = up ? c2_[0] : c2_[1]; c1 = keep + __shfl_xor(send, 2); }
            c1 += __shfl_xor(c1, 1);
            const int e = ((lane >> 5) << 4) | (((lane >> 4) & 1) << 3) | (((lane >> 3) & 1) << 2) | (((lane >> 2) & 1) << 1) | ((lane >> 1) & 1);
            float lv = c1 + F.b_router[e];
            float tv[4]; int ti[4];
#pragma unroll
            for (int r = 0; r < 4; ++r) { float bv = lv; int bi = e;
#pragma unroll
                for (int o = 1; o < 64; o <<= 1) { const float ov = __shfl_xor(bv, o); const int oi = __shfl_xor(bi, o); if (ov > bv || (ov == bv && oi < bi)) { bv = ov; bi = oi; } }
                tv[r] = bv; ti[r] = bi; if (e == bi) lv = -3.0e38f; }
            const float e1 = __expf(tv[1] - tv[0]), e2 = __expf(tv[2] - tv[0]), e3 = __expf(tv[3] - tv[0]); const float is = 1.f / (1.f + e1 + e2 + e3);
            if (lane < 4) { const int ee = lane == 0 ? ti[0] : lane == 1 ? ti[1] : lane == 2 ? ti[2] : ti[3]; const float ww = (lane == 0 ? 1.f : lane == 1 ? e1 : lane == 2 ? e2 : e3) * is;
                teL[rr * 4 + lane] = ee; twL[rr * 4 + lane] = ww; lrL[rr * 4 + lane] = __hip_atomic_fetch_add(&lcnt[ee], 1, __ATOMIC_RELAXED, __HIP_MEMORY_SCOPE_WORKGROUP); }
        }
        __syncthreads();
        if (F.tid < NE) { const int n = lcnt[F.tid]; gbase[F.tid] = n ? atomicAdd(&cnt[F.tid], n) : 0; }
        __syncthreads();
        if (F.tid < 256) { const int rr = F.tid >> 2, k = F.tid & 3, t = blk * 64 + rr; const int ee = teL[F.tid], p = gbase[ee] + lrL[F.tid];
            lists[ee * T + p] = t; TE[t * 4 + k] = ee; TW[t * 4 + k] = twL[F.tid]; TP[t * 4 + k] = p; }
    }
    __syncthreads();
}

__device__ __forceinline__ void p10_final(Frame& F) {
    const float* mod = (const float*)(F.ws + WS_MOD); const bf16_t* YE = (const bf16_t*)(F.ws + WS_YE);
    const int* TE = (const int*)(F.ws + WS_TE); const float* TW = (const float*)(F.ws + WS_TW); const int* TP = (const int*)(F.ws + WS_TP);
    LAS int* cntL = (LAS int*)(F.lds + LX_CNT); LAS int* baseL = (LAS int*)(F.lds + LX_BASE);
    const int* cnt = (const int*)(F.ws + WS_CTL) + CW_CNT;
    __syncthreads();
    if (F.tid < NE) cntL[F.tid] = cnt[F.tid];
    __syncthreads();
    if (F.tid == 0) { int s = 0; for (int e = 0; e < NE; ++e) { baseL[e] = s; s += cntL[e]; } }
    __syncthreads();
    for (int blk = F.bx; blk < T / 64; blk += F.G) {
        const int b = (blk * 64) / S; const float* g2 = mod + b * 6144 + 5120;
        for (int rr = F.wave; rr < 64; rr += NWAVES) {
            const int row = blk * 64 + rr, lane = F.lane;
            f32x4* xr = (f32x4*)(F.out + (size_t)row * D) + lane;
            f32x4 f[4];
#pragma unroll
            for (int j = 0; j < 4; ++j) f[j] = (f32x4){0.f, 0.f, 0.f, 0.f};
#pragma unroll
            for (int k = 0; k < 4; ++k) { const int e = TE[row * 4 + k]; const float w = TW[row * 4 + k]; const size_t yr = (size_t)(baseL[e] + TP[row * 4 + k]);
                const u32x2* yp = (const u32x2*)(YE + yr * D) + lane;
#pragma unroll
                for (int j = 0; j < 4; ++j) { const u32x2 y = yp[64 * j]; f[j].x += w * bf_lo(y.x); f[j].y += w * bf_hi(y.x); f[j].z += w * bf_lo(y.y); f[j].w += w * bf_hi(y.y); } }
            f32x4 v[4]; float s = 0.f;
#pragma unroll
            for (int j = 0; j < 4; ++j) { const f32x4 gg = *(const f32x4*)(g2 + 4 * lane + 256 * j); v[j] = xr[64 * j] * ALPHA + gg * f[j]; s += (v[j].x + v[j].y) + (v[j].z + v[j].w); }
            const float mean = wave_sum(s) * (1.f / D); float s2 = 0.f;
#pragma unroll
            for (int j = 0; j < 4; ++j) { v[j] = v[j] - mean; s2 += (v[j].x * v[j].x + v[j].y * v[j].y) + (v[j].z * v[j].z + v[j].w * v[j].w); }
            const float rstd = 1.f / sqrtf(wave_sum(s2) * (1.f / D) + 1e-5f);
#pragma unroll
            for (int j = 0; j < 4; ++j) { const int k = 4 * lane + 256 * j; const f32x4 gg = *(const f32x4*)(F.ln2_g + k), bb = *(const f32x4*)(F.ln2_b + k); xr[64 * j] = v[j] * rstd * gg + bb; }
        }
    }
}
constexpr int N_PHASES = 11;
__global__ void __launch_bounds__(NTHR, 2) mega_fwd(KP kp) {
    extern __shared__ __attribute__((aligned(16))) unsigned char lds_raw[];
    Frame F;
    F.lds = (LAS unsigned char*)lds_raw; F.tid = threadIdx.x; F.lane = F.tid & 63; F.wave = __builtin_amdgcn_readfirstlane(F.tid >> 6); F.G = gridDim.x; F.bx = blockIdx.x;
    F.x = kp.in[0]; F.c = kp.in[1]; F.pos = (const int*)kp.in[2]; F.w_ada = kp.in[3]; F.b_ada = kp.in[4]; F.w_in = kp.in[5]; F.rms_q = kp.in[6]; F.w_uq = kp.in[7]; F.rms_kv = kp.in[8]; F.w_ukv = kp.in[9];
    F.rel_bias = kp.in[10]; F.wba = kp.in[11]; F.wbb = kp.in[12]; F.w_out = kp.in[13]; F.ln1_g = kp.in[14]; F.ln1_b = kp.in[15]; F.w_router = kp.in[16]; F.b_router = kp.in[17];
    F.w_gate = kp.in[18]; F.b_gate = kp.in[19]; F.w_up = kp.in[20]; F.b_up = kp.in[21]; F.w_down = kp.in[22]; F.b_down = kp.in[23]; F.ln2_g = kp.in[24]; F.ln2_b = kp.in[25];
    F.out = kp.out; F.ws = kp.ws;
    for (int u = F.tid; u < (LDS_BYTES - LDSX) / 4; u += NTHR) ((LAS unsigned*)(F.lds + LDSX))[u] = 0u;
    __syncthreads();
    const int lo = kp.ph_lo, hi = kp.ph_hi;
    const bool multi = (hi - lo) > 1;
    XcdBarrier bar; bar.bar = (unsigned*)(F.ws + WS_CTL) + CW_BAR; bar.x = 0; bar.st = nullptr;
    if (multi) bar = xcd_barrier_post((unsigned*)(F.ws + WS_CTL) + CW_BAR, (volatile LAS unsigned*)(F.lds + LX_MISC) + 8);
#ifndef FK_PHASE_MASK
#define FK_PHASE_MASK 0x7ff
#endif
#define IN(k) (((FK_PHASE_MASK >> (k)) & 1) && lo <= (k) && (k) < hi)
#define SEAM(k) do { if (IN(k) && IN((k) + 1)) xcd_barrier(bar); } while (0)
    unsigned char* ws = F.ws;
    LAS unsigned char* ring = F.lds;

    if (IN(0)) { p0_prologue(F); } SEAM(0);
    if (IN(1)) { p1_h1(F); } SEAM(1);
    if (IN(2)) {
        pg8::StaticOrder S; S.init(ws + WS_H1, ws + WS_WIN, T, NPAD_WIN, D, F.G, F.bx);
        EpiZ E{(bf16_t*)(ws + WS_QA), (bf16_t*)(ws + WS_KA), (bf16_t*)(ws + WS_VA), (bf16_t*)(ws + WS_CQ), (bf16_t*)(ws + WS_CKV), (bf16_t*)(ws + WS_KPE), (bf16_t*)(ws + WS_GA), (bf16_t*)(ws + WS_GB),
               (float*)(ws + WS_SSQQ), (float*)(ws + WS_SSQKV), (const f32x2*)(ws + WS_CS)};
        pg8::gemm_phase<EpiZ, pg8::StaticOrder, true, false>(ring, D, S, E);
    } SEAM(2);
    if (IN(3)) {
        { pg8::StaticOrder S; S.init(ws + WS_CQ, ws + WS_WUQ, T, 768, 384, F.G, F.bx);
          EpiQB E{(bf16_t*)(ws + WS_QB), (const float*)(ws + WS_SSQQ), (const f32x2*)(ws + WS_CS)};
          pg8::gemm_phase<EpiQB, pg8::StaticOrder, true, false>(ring, 384, S, E); }
        { pg8::StaticOrder S; S.init(ws + WS_CKV, ws + WS_WUKV, T, 1024, 256, F.G, F.bx);
          EpiKVB E{(bf16_t*)(ws + WS_KB), (bf16_t*)(ws + WS_VB), (const float*)(ws + WS_SSQKV)};
          pg8::gemm_phase<EpiKVB, pg8::StaticOrder, true, false>(ring, 256, S, E); }
    } SEAM(3);
    if (IN(4)) { p4_attention(F); } SEAM(4);
    if (IN(5)) {
        { pg8::StaticOrder S; S.init(ws + WS_YA, ws + WS_WBA, T, D, 512, F.G, F.bx);
          EpiMG<0> E{(bf16_t*)(ws + WS_MG), (const bf16_t*)(ws + WS_GA)};
          pg8::gemm_phase<EpiMG<0>, pg8::StaticOrder, true, false>(ring, 512, S, E); }
        VM_WAIT(); __syncthreads();
        { pg8::StaticOrder S; S.init(ws + WS_YB, ws + WS_WBB, T, D, 512, F.G, F.bx);
          EpiMG<1> E{(bf16_t*)(ws + WS_MG), (const bf16_t*)(ws + WS_GB)};
          pg8::gemm_phase<EpiMG<1>, pg8::StaticOrder, true, false>(ring, 512, S, E); }
    } SEAM(5);
    if (IN(6)) {
        pg8::StaticOrder S; S.init(ws + WS_MG, ws + WS_WOUT, T, D, D, F.G, F.bx);
        EpiR1 E{F.out, F.x, (const float*)(ws + WS_MOD)};
        pg8::gemm_phase<EpiR1, pg8::StaticOrder, true, false>(ring, D, S, E);
    } SEAM(6);
    if (IN(7)) { p7_ln_router(F); } SEAM(7);
    if (IN(8)) {
        const int nloc = build_group_tables(F, 8, true);
        GroupSched S{(const LAS int*)(F.lds + LX_UTAB), (const LAS unsigned*)(F.lds + LX_GTAB), (const char*)(ws + WS_H2), (const char*)(ws + WS_WGU), (size_t)2048 * D, D / 2, nloc, 1};
        EpiGU E{ws + WS_HE, F.b_gate, F.b_up};
        pg8::gemm_phase<EpiGU, GroupSched, true, true, true>(ring, D / 2, S, E);
    } SEAM(8);
    if (IN(9)) {
        const int nloc = build_group_tables(F, 4, false);
        GroupSched S{(const LAS int*)(F.lds + LX_UTAB), (const LAS unsigned*)(F.lds + LX_GTAB), (const char*)(ws + WS_HE), (const char*)(ws + WS_WD), (size_t)D * D, D / 2, nloc, 0};
        EpiDown E{(bf16_t*)(ws + WS_YE), F.b_down};
        pg8::gemm_phase<EpiDown, GroupSched, true, false, true>(ring, D / 2, S, E);
    } SEAM(9);
    if (IN(10)) { p10_final(F); }
#undef IN
#undef SEAM
}

static int g_grid = 0;
static bool fast_setup() {
    if (g_grid) return g_grid > 0;
    int dev = 0, cus = 0;
    if (hipGetDevice(&dev) != hipSuccess || hipDeviceGetAttribute(&cus, hipDeviceAttributeMultiprocessorCount, dev) != hipSuccess) { g_grid = -1; return false; }
    if (hipFuncSetAttribute((const void*)mega_fwd, hipFuncAttributeMaxDynamicSharedMemorySize, LDS_BYTES) != hipSuccess) { fprintf(stderr, "hipFuncSetAttribute failed\n"); g_grid = -1; return false; }
    int per_cu = 0;
    if (hipOccupancyMaxActiveBlocksPerMultiprocessor(&per_cu, (const void*)mega_fwd, NTHR, LDS_BYTES) != hipSuccess || per_cu < 1) fprintf(stderr, "occupancy query says %d\n", per_cu);
    (void)hipGetLastError();
    g_grid = cus;
    return true;
}
static void launch_phases(void* const* d_in, float* out, void* d_ws, hipStream_t st, int lo, int hi) {
    KP kp{};
    for (int i = 0; i < 26; ++i) kp.in[i] = (const float*)d_in[i];
    kp.out = out; kp.ws = (unsigned char*)d_ws; kp.ph_lo = lo; kp.ph_hi = hi;
    hipLaunchKernelGGL(mega_fwd, dim3(g_grid), dim3(NTHR), LDS_BYTES, st, kp);
}
}
#ifndef FK_LAUNCHES
#define FK_LAUNCHES 1
#endif
extern "C" void kernel_launch(void* const* d_in, const int* in_sizes, int n_in, void* d_out, int out_size, void* d_ws, size_t ws_size, hipStream_t stream) {
    (void)in_sizes; (void)n_in; (void)out_size;
    if (!fk::fast_setup()) return;
    if (ws_size < fk::WS_END) { fprintf(stderr, "workspace too small: %zu\n", ws_size); return; }
    (void)hipMemsetAsync(d_ws, 0, fk::CTL_ZERO_BYTES, stream);
    if (FK_LAUNCHES == 1) fk::launch_phases(d_in, (float*)d_out, d_ws, stream, 0, fk::N_PHASES);
    else for (int p = 0; p < fk::N_PHASES; ++p) { fk::launch_phases(d_in, (float*)d_out, d_ws, stream, p, p + 1);
#ifdef FK_REPEAT
        if (p == FK_REPEAT) fk::launch_phases(d_in, (float*)d_out, d_ws, stream, p, p + 1);
#endif
    }
}
```
